# Optimizing an MI355X kernel written in HIP

```python
import math
import jax, jax.numpy as jnp
from jax import lax
import numpy as np

D_MODEL = 1024
BATCH = 32
SEQ = 2048
DEPTH = 4

CHUNK = 64
Q_BLOCK = 128
N_MEM = 256
EPS = 1e-6

DA_HEADS = 4
DA_DIM = 64
DA_VDIM = 2 * DA_DIM
SB_HEADS = 4
SB_DIM = 64
MLA_HEADS = 4
MLA_NOPE = 64
MLA_ROPE = 32
MLA_V = 64
MLA_Q_RANK = 256
MLA_KV_RANK = 128
ROPE_THETA = 10000.0
NUM_BUCKETS = 32
MAX_DISTANCE = 128
MEM_HEADS = 4
MEM_DIM = 64
D_FF = 4 * D_MODEL

MIX_WIDTH = DA_HEADS * DA_VDIM + SB_HEADS * SB_DIM + MLA_HEADS * MLA_V
IN_SIZES = (DA_HEADS * 2 * DA_DIM, DA_HEADS * 2 * DA_DIM, DA_HEADS * DA_VDIM,
            SB_HEADS * SB_DIM, SB_HEADS * SB_DIM, SB_HEADS * SB_DIM,
            MLA_Q_RANK, MLA_KV_RANK, MLA_ROPE)
IN_COLS = sum(IN_SIZES)

kernel_name = "hybrid_chunk_causal_diff_sb_mla_trunk"


def rms_norm(x, g):
    xf = x.astype(jnp.float32)
    y = xf * lax.rsqrt(jnp.mean(xf * xf, axis=-1, keepdims=True) + EPS)
    return (y * g.astype(jnp.float32)).astype(x.dtype)


def split_points():
    pts, acc = [], 0
    for n in IN_SIZES[:-1]:
        acc += n
        pts.append(acc)
    return pts


def t5_bucket(rel):
    nb = NUM_BUCKETS // 2
    bucket = (rel > 0).astype(jnp.int32) * nb
    n = jnp.abs(rel)
    max_exact = nb // 2
    is_small = n < max_exact
    large = max_exact + (jnp.log(jnp.maximum(n, 1).astype(jnp.float32) / max_exact)
                         / math.log(MAX_DISTANCE / max_exact) * (nb - max_exact)).astype(jnp.int32)
    large = jnp.minimum(large, nb - 1)
    return bucket + jnp.where(is_small, n, large)


def chunk_mask(q_pos, k_pos):
    return (k_pos[None, :] // CHUNK) <= (q_pos[:, None] // CHUNK)


def rope(x, pos):
    half = MLA_ROPE // 2
    freqs = ROPE_THETA ** (-jnp.arange(half, dtype=jnp.float32) / half)
    ang = pos.astype(jnp.float32)[:, None] * freqs[None, :]
    cos = jnp.cos(ang)[None, :, None, :]
    sin = jnp.sin(ang)[None, :, None, :]
    xf = x.astype(jnp.float32)
    x1, x2 = xf[..., :half], xf[..., half:]
    return jnp.concatenate([x1 * cos - x2 * sin, x2 * cos + x1 * sin], axis=-1).astype(x.dtype)


def over_query_blocks(block_fn, q):
    b, s = q.shape[0], q.shape[1]
    nb = s // Q_BLOCK
    qs = jnp.moveaxis(q.reshape((b, nb, Q_BLOCK) + q.shape[2:]), 1, 0)
    out = lax.map(lambda a: block_fn(a[0], a[1]), (jnp.arange(nb, dtype=jnp.int32), qs))
    out = jnp.moveaxis(out, 0, 1)
    return out.reshape((b, s) + out.shape[3:])


def diff_attention(q, k, v, rel_bias, q_g, k_g, lam_p, subln_g, layer):
    b, s, _ = q.shape
    q = rms_norm(q.reshape(b, s, DA_HEADS, 2, DA_DIM), q_g)
    k = rms_norm(k.reshape(b, s, DA_HEADS, 2, DA_DIM), k_g)
    v = v.reshape(b, s, DA_HEADS, DA_VDIM)
    lam_init = 0.8 - 0.6 * math.exp(-0.3 * layer)
    lp = lam_p.astype(jnp.float32)
    lam = jnp.exp(jnp.sum(lp[0] * lp[1])) - jnp.exp(jnp.sum(lp[2] * lp[3])) + lam_init
    k_pos = jnp.arange(s, dtype=jnp.int32)

    def block(i, qb):
        q_pos = i * Q_BLOCK + jnp.arange(Q_BLOCK, dtype=jnp.int32)
        logits = jnp.einsum('bqhmd,bkhmd->bhmqk', qb, k,
                            preferred_element_type=jnp.float32) * (DA_DIM ** -0.5)
        bias = rel_bias[t5_bucket(k_pos[None, :] - q_pos[:, None])].astype(jnp.float32)
        bias = bias.reshape(Q_BLOCK, s, DA_HEADS, 2).transpose(2, 3, 0, 1)
        logits = jnp.where(chunk_mask(q_pos, k_pos), logits + bias, -jnp.inf)
        p = jax.nn.softmax(logits, axis=-1)
        a = p[:, :, 0] - lam * p[:, :, 1]
        return jnp.einsum('bhqk,bkhe->bqhe', a.astype(v.dtype), v)

    o = over_query_blocks(block, q)
    o = rms_norm(o, subln_g) * (1.0 - lam_init)
    return o.reshape(b, s, DA_HEADS * DA_VDIM)


def stick_breaking(q, k, v, out_g):
    b, s, _ = q.shape
    q = q.reshape(b, s, SB_HEADS, SB_DIM)
    k = k.reshape(b, s, SB_HEADS, SB_DIM)
    v = v.reshape(b, s, SB_HEADS, SB_DIM)
    k_pos = jnp.arange(s, dtype=jnp.int32)

    def block(i, qb):
        q_pos = i * Q_BLOCK + jnp.arange(Q_BLOCK, dtype=jnp.int32)
        z = jnp.einsum('bqhd,bkhd->bhqk', qb, k,
                       preferred_element_type=jnp.float32) * (SB_DIM ** -0.5)
        earlier = k_pos[None, :] < q_pos[:, None]
        log_beta = jax.nn.log_sigmoid(z)
        log_1m_beta = jnp.where(earlier, jax.nn.log_sigmoid(-z), 0.0)
        later = lax.cumsum(log_1m_beta, axis=3, reverse=True) - log_1m_beta
        a = jnp.where(earlier, jnp.exp(log_beta + later), 0.0)
        return jnp.einsum('bhqk,bkhd->bqhd', a.astype(v.dtype), v)

    o = over_query_blocks(block, q)
    return rms_norm(o, out_g).reshape(b, s, SB_HEADS * SB_DIM)


def latent_attention(c_q, c_kv, k_r, pos, cq_g, ckv_g, w_uq, w_ukv, q_g, k_g, out_g):
    b, s, _ = c_q.shape
    q = (rms_norm(c_q, cq_g) @ w_uq).reshape(b, s, MLA_HEADS, MLA_NOPE + MLA_ROPE)
    kv = (rms_norm(c_kv, ckv_g) @ w_ukv).reshape(b, s, MLA_HEADS, MLA_NOPE + MLA_V)
    k_nope, v = kv[..., :MLA_NOPE], kv[..., MLA_NOPE:]
    k = jnp.concatenate([k_nope, jnp.broadcast_to(k_r[:, :, None, :], (b, s, MLA_HEADS, MLA_ROPE))], axis=-1)
    q = rms_norm(q, q_g)
    k = rms_norm(k, k_g)
    q = jnp.concatenate([q[..., :MLA_NOPE], rope(q[..., MLA_NOPE:], pos)], axis=-1)
    k = jnp.concatenate([k[..., :MLA_NOPE], rope(k[..., MLA_NOPE:], pos)], axis=-1)
    scale = (MLA_NOPE + MLA_ROPE) ** -0.5
    k_pos = jnp.arange(s, dtype=jnp.int32)

    def block(i, qb):
        q_pos = i * Q_BLOCK + jnp.arange(Q_BLOCK, dtype=jnp.int32)
        logits = jnp.einsum('bqhd,bkhd->bhqk', qb, k, preferred_element_type=jnp.float32) * scale
        logits = jnp.where(chunk_mask(q_pos, k_pos), logits, -jnp.inf)
        p = jax.nn.softmax(logits, axis=-1)
        return jnp.einsum('bhqk,bkhd->bqhd', p.astype(v.dtype), v)

    o = over_query_blocks(block, q)
    return rms_norm(o, out_g).reshape(b, s, MLA_HEADS * MLA_V)


def memory_attention(h, mem, mem_g, w_q, w_kv, q_g, k_g, w_o):
    b, s, _ = h.shape
    n = mem.shape[1]
    m = rms_norm(mem, mem_g)
    q = rms_norm((h @ w_q).reshape(b, s, MEM_HEADS, MEM_DIM), q_g)
    kv = (m @ w_kv).reshape(b, n, 2, MEM_HEADS, MEM_DIM)
    k = rms_norm(kv[:, :, 0], k_g)
    v = kv[:, :, 1]
    logits = jnp.einsum('bqhd,bkhd->bhqk', q, k, preferred_element_type=jnp.float32) * (MEM_DIM ** -0.5)
    p = jax.nn.softmax(logits, axis=-1)
    o = jnp.einsum('bhqk,bkhd->bqhd', p.astype(v.dtype), v).reshape(b, s, MEM_HEADS * MEM_DIM)
    return o @ w_o


def setup_inputs(seed: int = 0) -> dict:
    key = jax.random.key(seed)
    keys = iter(jax.random.split(key, 40))

    def nrm(shape, scale):
        return jax.random.normal(next(keys), shape, jnp.float32) * scale

    def gain(shape):
        return 1.0 + nrm(shape, 0.02)

    L = DEPTH
    return {
        "x": nrm((BATCH, SEQ, D_MODEL), 1.0),
        "mem": nrm((BATCH, N_MEM, D_MODEL), 1.0),
        "rel_bias": nrm((NUM_BUCKETS, DA_HEADS * 2), 0.2),
        "mix_norm_g": gain((L, D_MODEL)),
        "w_in": nrm((L, D_MODEL, IN_COLS), D_MODEL ** -0.5),
        "da_q_norm_g": gain((L, DA_DIM)),
        "da_k_norm_g": gain((L, DA_DIM)),
        "da_lambda": nrm((L, 4, DA_DIM), 0.1),
        "da_subln_g": gain((L, DA_VDIM)),
        "sb_out_g": gain((L, SB_DIM)),
        "mla_cq_norm_g": gain((L, MLA_Q_RANK)),
        "mla_ckv_norm_g": gain((L, MLA_KV_RANK)),
        "w_mla_uq": nrm((L, MLA_Q_RANK, MLA_HEADS * (MLA_NOPE + MLA_ROPE)), MLA_Q_RANK ** -0.5),
        "w_mla_ukv": nrm((L, MLA_KV_RANK, MLA_HEADS * (MLA_NOPE + MLA_V)), MLA_KV_RANK ** -0.5),
        "mla_q_norm_g": gain((L, MLA_NOPE + MLA_ROPE)),
        "mla_k_norm_g": gain((L, MLA_NOPE + MLA_ROPE)),
        "mla_out_g": gain((L, MLA_V)),
        "w_out": nrm((L, MIX_WIDTH, D_MODEL), 0.5 * MIX_WIDTH ** -0.5),
        "memx_norm_g": gain((L, D_MODEL)),
        "mem_norm_g": gain((L, D_MODEL)),
        "w_mem_q": nrm((L, D_MODEL, MEM_HEADS * MEM_DIM), D_MODEL ** -0.5),
        "w_mem_kv": nrm((L, D_MODEL, 2 * MEM_HEADS * MEM_DIM), D_MODEL ** -0.5),
        "mem_q_norm_g": gain((L, MEM_DIM)),
        "mem_k_norm_g": gain((L, MEM_DIM)),
        "w_mem_o": nrm((L, MEM_HEADS * MEM_DIM, D_MODEL), 0.5 * (MEM_HEADS * MEM_DIM) ** -0.5),
        "ffn_norm_g": gain((L, D_MODEL)),
        "w_ff1": nrm((L, D_MODEL, D_FF), D_MODEL ** -0.5),
        "w_ff2": nrm((L, D_FF, D_MODEL), 0.5 * D_FF ** -0.5),
    }


def reference(x, mem, rel_bias, mix_norm_g, w_in, da_q_norm_g, da_k_norm_g, da_lambda, da_subln_g,
              sb_out_g, mla_cq_norm_g, mla_ckv_norm_g, w_mla_uq, w_mla_ukv, mla_q_norm_g, mla_k_norm_g,
              mla_out_g, w_out, memx_norm_g, mem_norm_g, w_mem_q, w_mem_kv, mem_q_norm_g, mem_k_norm_g,
              w_mem_o, ffn_norm_g, w_ff1, w_ff2):
    s = x.shape[1]
    pos = jnp.arange(s, dtype=jnp.int32)
    pts = split_points()
    for layer in range(DEPTH):
        h = rms_norm(x, mix_norm_g[layer])
        proj = h @ w_in[layer]
        da_q, da_k, da_v, sb_q, sb_k, sb_v, c_q, c_kv, k_r = jnp.split(proj, pts, axis=-1)
        y_a = diff_attention(da_q, da_k, da_v, rel_bias, da_q_norm_g[layer], da_k_norm_g[layer],
                             da_lambda[layer], da_subln_g[layer], layer)
        y_b = stick_breaking(sb_q, sb_k, sb_v, sb_out_g[layer])
        y_c = latent_attention(c_q, c_kv, k_r, pos, mla_cq_norm_g[layer], mla_ckv_norm_g[layer],
                               w_mla_uq[layer], w_mla_ukv[layer], mla_q_norm_g[layer],
                               mla_k_norm_g[layer], mla_out_g[layer])
        y = jnp.concatenate([y_a, y_b, y_c], axis=-1)
        x = x + y @ w_out[layer]
        h = rms_norm(x, memx_norm_g[layer])
        x = x + memory_attention(h, mem, mem_norm_g[layer], w_mem_q[layer], w_mem_kv[layer],
                                 mem_q_norm_g[layer], mem_k_norm_g[layer], w_mem_o[layer])
        h = rms_norm(x, ffn_norm_g[layer])
        x = x + jnp.square(jax.nn.relu(h @ w_ff1[layer])) @ w_ff2[layer]
    return x
```

```cpp
#include <hip/hip_runtime.h>
#include <hip/hip_cooperative_groups.h>
#include <cstdio>
#include <cstdint>
namespace cg = cooperative_groups;

#ifndef MK_MULTI
#define MK_MULTI 0
#endif
#ifndef PROBE_DUP
#define PROBE_ATT_ONLY -1
#define PROBE_COND false
#define PROBE_BACK 1
#define PROBE_DUP -1
#endif
#ifndef SB_EARLY
#define SB_EARLY 1
#endif

#define LAS __attribute__((address_space(3)))
#define DI __device__ __forceinline__
typedef unsigned short bf16_t;
typedef short bf16x8 __attribute__((ext_vector_type(8)));
typedef short s16x4 __attribute__((ext_vector_type(4)));
typedef float f32x4 __attribute__((ext_vector_type(4)));
typedef float f32x16 __attribute__((ext_vector_type(16)));
typedef unsigned u32x4 __attribute__((ext_vector_type(4)));
typedef unsigned u32x2 __attribute__((ext_vector_type(2)));
typedef float f32x2_t __attribute__((ext_vector_type(2)));
typedef __bf16 bf16x2_t __attribute__((ext_vector_type(2)));

constexpr int BATCH = 32, SEQ = 2048, DM = 1024, DEPTH = 4, NMEM = 256, DFF = 4096;
constexpr int MT = BATCH * SEQ;
constexpr int MROWS = BATCH * NMEM;
constexpr int LDP = 2048;
constexpr float EPS = 1e-6f;
constexpr float LOG2E = 1.4426950408889634f;
constexpr float QS64 = 0.125f * LOG2E;
constexpr float QS96 = 0.10206207261596577f * LOG2E;

constexpr size_t MiB = 1u << 20;
constexpr size_t WS_XB = 0;
constexpr size_t WS_R = 128 * MiB;
constexpr size_t WS_PROJ = WS_R;
constexpr size_t WS_VT = WS_R + 256 * MiB;
constexpr size_t WS_QM = WS_R + 352 * MiB;
constexpr size_t WS_KN = WS_R + 416 * MiB;
constexpr size_t WS_KM = WS_R + 448 * MiB;
constexpr size_t WS_VTM = WS_R + 496 * MiB;
constexpr size_t WS_H = WS_R;
constexpr size_t WS_Y = 656 * MiB;
constexpr size_t WS_QMEM = WS_Y;
constexpr size_t WS_OMEM = WS_Y + 32 * MiB;
constexpr size_t WS_W = 784 * MiB;
constexpr size_t WL_STRIDE = 26 * MiB;
constexpr size_t WL_IN = 0, WL_UQ = 5767168, WL_UK = 6029312, WL_UV = 6094848, WL_OUT = 6160384, WL_MQ = 8257536,
                 WL_MKV = 8781824, WL_MO = 9830400, WL_F1 = 10354688, WL_F2 = 18743296;
constexpr size_t WS_MEMB = 888 * MiB;
constexpr size_t WS_KMEM = 904 * MiB;
constexpr size_t WS_VTMEM = 920 * MiB;
constexpr size_t WS_SS = 936 * MiB;
constexpr size_t WS_RSTDM = 940 * MiB;
constexpr size_t WS_RSTD = 941 * MiB;
constexpr size_t WS_BAR = 942 * MiB;
constexpr size_t WS_CQS = 943 * MiB;
constexpr size_t WS_END = 945 * MiB;

constexpr int LDS_BYTES = 135168;

struct Args { const float* in[28]; float* out; unsigned char* ws; int ph_lo, ph_hi; };

DI unsigned cvtpk(float lo, float hi) { f32x2_t v = {lo, hi}; bf16x2_t b = __builtin_convertvector(v, bf16x2_t); return __builtin_bit_cast(unsigned, b); }
DI float shx(float v, int mask, int lane) { return __builtin_bit_cast(float, __builtin_amdgcn_ds_bpermute((lane ^ mask) << 2, __builtin_bit_cast(int, v))); }
DI float bflo(unsigned w) { return __uint_as_float(w << 16); }
DI float bfhi(unsigned w) { return __uint_as_float(w & 0xffff0000u); }
DI float rstd16(const float* SS, int row, float invn) {
    const f32x4* p = (const f32x4*)(SS + (size_t)row * 16); const f32x4 a = p[0], b = p[1], c = p[2], d = p[3];
    const float s = (((a.x + a.y) + (a.z + a.w)) + ((b.x + b.y) + (b.z + b.w))) + (((c.x + c.y) + (c.z + c.w)) + ((d.x + d.y) + (d.z + d.w)));
    return rsqrtf(s * invn + EPS);
}

namespace pg8 {
constexpr int BM = 256, BK = 64, HALF = 128, HTB = HALF * BK * 2, STAGE_BYTES = 8 * HTB, NXCD = 8, WGM = 8;
__host__ __device__ __forceinline__ int lds_byte(int r, int c) { const int st = (r >> 4) * 2 + (c >> 5), rr = r & 15, cc = c & 31, ob = rr * 64 + cc * 2; return st * 1024 + (ob ^ (((ob >> 9) & 1) << 5)); }
__host__ __device__ __forceinline__ void stage_rc(int b, int& R, int& C) { const int st = b / 1024, sb = b % 1024, swz = sb ^ (((sb >> 9) & 1) << 5); R = (st >> 1) * 16 + swz / 64; C = (st & 1) * 32 + (swz % 64) / 2; }
__host__ __device__ __forceinline__ int perm32(int rho) { const int n = rho >> 4, i = rho & 15; return 8 * (i >> 2) + 4 * n + (i & 3); }
struct Unit { int pm, pn; };
struct Gemm { const bf16_t* A; const bf16_t* Bt; int M, N, K, lda, ldb; };
struct StaticOrder {
    int nM, nN, nwg, G, c, rowmaj;
    __device__ void init(int M, int N, int G_, int c_, int rm) { nM = M / BM; nN = N / BM; nwg = nM * nN; G = G_; c = c_; rowmaj = rm; }
    __device__ bool next(int i, Unit& u) const {
        if (rowmaj) { const int pm = c + (i / nN) * G; if (pm >= nM) return false; u.pm = pm; u.pn = i % nN; return true; }
        const long L = (long)i * G + c; if (L >= nwg) return false;
        int wgid = (int)L; { const int q = nwg / NXCD, r = nwg % NXCD, xcd = wgid % NXCD, off = wgid / NXCD; wgid = (xcd < r ? xcd * (q + 1) : r * (q + 1) + (xcd - r) * q) + off; }
        const int nig = WGM * nN, gid = wgid / nig, fm = gid * WGM, gsz = (nM - fm) < WGM ? (nM - fm) : WGM;
        u.pm = fm + ((wgid % nig) % gsz); u.pn = (wgid % nig) / gsz; return true;
    }
};

template <int ACT  > struct EpiRow {
    static constexpr bool PERM = true;
    bf16_t* O; int ldc; const float* SS; float invn;
    DI void operator()(const f32x4 (&acc)[2][2][4][2], const Unit& u, int wr, int wc, int fr, int fq) const {
        const int row0 = u.pm * BM + wr * 64 + fr, col0 = u.pn * BM + wc * 32 + 8 * fq;
#pragma unroll
        for (int ai = 0; ai < 2; ++ai)
#pragma unroll
            for (int m = 0; m < 4; ++m) { const int row = row0 + ai * HALF + m * 16; float sc = 1.f; if (SS) { if (invn > 0.f) { const f32x4 q4 = *(const f32x4*)(SS + (size_t)row * 4); sc = rsqrtf(((q4.x + q4.y) + (q4.z + q4.w)) * invn + EPS); } else sc = SS[row]; }
                bf16_t* rowp = O + (size_t)row * ldc + col0;
#pragma unroll
                for (int bj = 0; bj < 2; ++bj) { f32x4 v0 = acc[ai][bj][m][0] * sc, v1 = acc[ai][bj][m][1] * sc;
                    if (ACT == 1) {
#pragma unroll
                        for (int e = 0; e < 4; ++e) { const float a = fmaxf(v0[e], 0.f), b = fmaxf(v1[e], 0.f); v0[e] = a * a; v1[e] = b * b; } }
                    u32x4 w; w.x = cvtpk(v0[0], v0[1]); w.y = cvtpk(v0[2], v0[3]); w.z = cvtpk(v1[0], v1[1]); w.w = cvtpk(v1[2], v1[3]);
                    if (ACT == 1) __builtin_nontemporal_store(w, (u32x4*)(rowp + bj * HALF));
                    else *(u32x4*)(rowp + bj * HALF) = w; }
                asm volatile("" ::: "memory"); }
    }
};
struct EpiCol {
    static constexpr bool PERM = true;
    bf16_t* O; int ldc; const float* SS; float invn;
    DI void operator()(const f32x4 (&acc)[2][2][4][2], const Unit& u, int wr, int wc, int fr, int fq) const {
        const int row0 = u.pm * BM + wr * 64 + fr, col0 = u.pn * BM + wc * 32 + 8 * fq;
#pragma unroll
        for (int bj = 0; bj < 2; ++bj) {
            float cs[8];
            if (invn > 0.f) {
#pragma unroll
                for (int j = 0; j < 8; ++j) { const f32x4 q4 = *(const f32x4*)(SS + (size_t)(col0 + bj * HALF + j) * 4); cs[j] = rsqrtf(((q4.x + q4.y) + (q4.z + q4.w)) * invn + EPS); }
            } else { const f32x4 c0 = *(const f32x4*)(SS + col0 + bj * HALF), c1 = *(const f32x4*)(SS + col0 + bj * HALF + 4);
              cs[0] = c0[0]; cs[1] = c0[1]; cs[2] = c0[2]; cs[3] = c0[3]; cs[4] = c1[0]; cs[5] = c1[1]; cs[6] = c1[2]; cs[7] = c1[3]; }
#pragma unroll
            for (int ai = 0; ai < 2; ++ai)
#pragma unroll
                for (int m = 0; m < 4; ++m) { const int row = row0 + ai * HALF + m * 16; bf16_t* rowp = O + (size_t)row * ldc + col0;
                    const f32x4 v0 = acc[ai][bj][m][0], v1 = acc[ai][bj][m][1];
                    u32x4 w; w.x = cvtpk(v0[0] * cs[0], v0[1] * cs[1]); w.y = cvtpk(v0[2] * cs[2], v0[3] * cs[3]);
                    w.z = cvtpk(v1[0] * cs[4], v1[1] * cs[5]); w.w = cvtpk(v1[2] * cs[6], v1[3] * cs[7]);
                    __builtin_nontemporal_store(w, (u32x4*)(rowp + bj * HALF)); }
            asm volatile("" ::: "memory");
        }
    }
};
struct EpiResid {
    static constexpr bool PERM = true;
    const float* fin; float* fout; bf16_t* xb; const bf16_t* loin; bf16_t* loout; float* SSo;
    DI void operator()(const f32x4 (&acc)[2][2][4][2], const Unit& u, int wr, int wc, int fr, int fq) const {
        const int col0 = u.pn * BM + wc * 32 + 8 * fq;
#pragma unroll
        for (int ai = 0; ai < 2; ++ai) {
            u32x4 pa[4][2], pb[4][2];
#pragma unroll
            for (int m = 0; m < 4; ++m) { const size_t off = (size_t)(u.pm * BM + ai * HALF + wr * 64 + m * 16 + fr) * DM + col0;
#pragma unroll
                for (int bj = 0; bj < 2; ++bj) {
                    if (fin) { pa[m][bj] = __builtin_nontemporal_load((const u32x4*)(fin + off + bj * HALF)); pb[m][bj] = __builtin_nontemporal_load((const u32x4*)(fin + off + bj * HALF + 4)); }
                    else { pa[m][bj] = *(const u32x4*)(xb + off + bj * HALF); pb[m][bj] = __builtin_nontemporal_load((const u32x4*)(loin + off + bj * HALF)); } } }
#pragma unroll
            for (int m = 0; m < 4; ++m) { const int row = u.pm * BM + ai * HALF + wr * 64 + m * 16 + fr; const size_t off = (size_t)row * DM + col0; float ss = 0.f;
#pragma unroll
                for (int bj = 0; bj < 2; ++bj) { const size_t o2 = off + bj * HALF;
                    float b[8];
                    if (fin) {
#pragma unroll
                        for (int j = 0; j < 4; ++j) { b[j] = __uint_as_float(pa[m][bj][j]); b[4 + j] = __uint_as_float(pb[m][bj][j]); }
                    } else {
#pragma unroll
                        for (int j = 0; j < 4; ++j) { b[2 * j] = bflo(pa[m][bj][j]) + bflo(pb[m][bj][j]); b[2 * j + 1] = bfhi(pa[m][bj][j]) + bfhi(pb[m][bj][j]); }
                    }
                    float o[8];
#pragma unroll
                    for (int j = 0; j < 4; ++j) { o[j] = b[j] + acc[ai][bj][m][0][j]; o[4 + j] = b[4 + j] + acc[ai][bj][m][1][j]; }
                    u32x4 w;
#pragma unroll
                    for (int j = 0; j < 4; ++j) w[j] = cvtpk(o[2 * j], o[2 * j + 1]);
                    if (!fin || loout || !fout) *(u32x4*)(xb + o2) = w;
                    if (loout) { u32x4 wl;
#pragma unroll
                        for (int j = 0; j < 4; ++j) wl[j] = cvtpk(o[2 * j] - bflo(w[j]), o[2 * j + 1] - bfhi(w[j]));
                        __builtin_nontemporal_store(wl, (u32x4*)(loout + o2)); }
                    if (fout) { __builtin_nontemporal_store((f32x4){o[0], o[1], o[2], o[3]}, (f32x4*)(fout + o2)); __builtin_nontemporal_store((f32x4){o[4], o[5], o[6], o[7]}, (f32x4*)(fout + o2 + 4)); }
#pragma unroll
                    for (int j = 0; j < 8; ++j) ss += o[j] * o[j]; }
                { const int ln = fr + 16 * fq; ss += shx(ss, 16, ln); ss += shx(ss, 32, ln); }
                if (fq == 0) SSo[(size_t)row * 16 + u.pn * 4 + wc] = ss; }
            asm volatile("" ::: "memory");
        }
    }
};
struct EpiGN {
    bf16_t* O; int ldc; const float* SS; const float* gq; const float* gk; float* CQ;
    DI void operator()(const f32x4 (&acc)[2][2][4][2], const Unit& u, int wr, int wc, int fr, int fq) const {
        if (u.pn >= 4) {
            const int row0 = u.pm * BM + wr * 64 + fr, col0 = u.pn * BM + wc * 32 + 8 * fq, ln = fr + 16 * fq;
#pragma unroll
            for (int ai = 0; ai < 2; ++ai)
#pragma unroll
                for (int m = 0; m < 4; ++m) { const int row = row0 + ai * HALF + m * 16; const float sc = SS[row]; bf16_t* rowp = O + (size_t)row * ldc + col0; float ss = 0.f;
                    float ss2 = 0.f;
#pragma unroll
                    for (int bj = 0; bj < 2; ++bj) { const f32x4 v0 = acc[ai][bj][m][0] * sc, v1 = acc[ai][bj][m][1] * sc;
                        if (bj == 1) ss2 = ((v0[0] * v0[0] + v0[1] * v0[1]) + (v0[2] * v0[2] + v0[3] * v0[3])) + ((v1[0] * v1[0] + v1[1] * v1[1]) + (v1[2] * v1[2] + v1[3] * v1[3]));
                        if (bj == 0 || u.pn == 6) ss += ((v0[0] * v0[0] + v0[1] * v0[1]) + (v0[2] * v0[2] + v0[3] * v0[3])) + ((v1[0] * v1[0] + v1[1] * v1[1]) + (v1[2] * v1[2] + v1[3] * v1[3]));
                        u32x4 w; w.x = cvtpk(v0[0], v0[1]); w.y = cvtpk(v0[2], v0[3]); w.z = cvtpk(v1[0], v1[1]); w.w = cvtpk(v1[2], v1[3]);
                        __builtin_nontemporal_store(w, (u32x4*)(rowp + bj * HALF)); }
                    if (u.pn >= 6) { ss += shx(ss, 16, ln); ss += shx(ss, 32, ln); if (fq == 0) CQ[(size_t)(u.pn - 6) * MT * 4 + (size_t)row * 4 + wc] = ss; }
                    if (u.pn == 7 && wc == 0) { ss2 += shx(ss2, 16, ln); ss2 += shx(ss2, 32, ln); if (fq == 0) CQ[(size_t)2 * MT * 4 + row] = ss2; }
                    asm volatile("" ::: "memory"); }
            return;
        }
        const float* gg = (u.pn < 2) ? gq : gk; const float ex = (u.pn < 2) ? QS64 : 1.f;
        const int row0 = u.pm * BM + wr * 64 + fr, ln = fr + 16 * fq;
        f32x4 g[2][2];
#pragma unroll
        for (int bj = 0; bj < 2; ++bj) { g[bj][0] = *(const f32x4*)(gg + 32 * bj + 8 * fq); g[bj][1] = *(const f32x4*)(gg + 32 * bj + 8 * fq + 4); }
#pragma unroll
        for (int ai = 0; ai < 2; ++ai)
#pragma unroll
            for (int m = 0; m < 4; ++m) { const int row = row0 + ai * HALF + m * 16; const float sc = SS[row];
                f32x4 v[2][2]; float ss = 0.f;
#pragma unroll
                for (int bj = 0; bj < 2; ++bj)
#pragma unroll
                    for (int n = 0; n < 2; ++n) { v[bj][n] = acc[ai][bj][m][n] * sc; ss += (v[bj][n][0] * v[bj][n][0] + v[bj][n][1] * v[bj][n][1]) + (v[bj][n][2] * v[bj][n][2] + v[bj][n][3] * v[bj][n][3]); }
                ss += shx(ss, 16, ln); ss += shx(ss, 32, ln);
                const float rs = rsqrtf(ss * (1.f / 64.f) + EPS) * ex;
                bf16_t* rowp = O + (size_t)row * ldc + u.pn * BM + wc * 64 + 8 * fq;
#pragma unroll
                for (int bj = 0; bj < 2; ++bj) { const f32x4 a0 = v[bj][0] * rs * g[bj][0], a1 = v[bj][1] * rs * g[bj][1];
                    u32x4 w; w.x = cvtpk(a0[0], a0[1]); w.y = cvtpk(a0[2], a0[3]); w.z = cvtpk(a1[0], a1[1]); w.w = cvtpk(a1[2], a1[3]);
                    __builtin_nontemporal_store(w, (u32x4*)(rowp + bj * 32)); }
                asm volatile("" ::: "memory"); }
    }
};
struct EpiKM {
    bf16_t* O; const float* SS; const float* gk; const bf16_t* proj; const float* krs;
    DI void operator()(const f32x4 (&acc)[2][2][4][2], const Unit& u, int wr, int wc, int fr, int fq) const {
        const int row0 = u.pm * BM + wr * 64 + fr, ln = fr + 16 * fq; const bool isx1 = fq < 2;
#pragma unroll
        for (int ai = 0; ai < 2; ++ai)
#pragma unroll
            for (int m = 0; m < 4; ++m) { const int row = row0 + ai * HALF + m * 16;
                const f32x4 q4 = *(const f32x4*)(SS + (size_t)row * 4); const float sc = rsqrtf(((q4.x + q4.y) + (q4.z + q4.w)) * (1.f / 128.f) + EPS);
                const u32x4 kr = *(const u32x4*)(proj + (size_t)row * LDP + 1920 + 8 * fq);
                int fqo = fq; asm volatile("" : "+v"(fqo));
                f32x4 v[2][2]; float ss = 0.f;
#pragma unroll
                for (int bj = 0; bj < 2; ++bj)
#pragma unroll
                    for (int n = 0; n < 2; ++n) { v[bj][n] = acc[ai][bj][m][n] * sc; ss += (v[bj][n][0] * v[bj][n][0] + v[bj][n][1] * v[bj][n][1]) + (v[bj][n][2] * v[bj][n][2] + v[bj][n][3] * v[bj][n][3]); }
                ss += shx(ss, 16, ln); ss += shx(ss, 32, ln);
                const float rs = rsqrtf((ss + krs[row]) * (1.f / 96.f) + EPS);
                bf16_t* rowp = O + (size_t)row * 384 + wc * 96 + 8 * fq;
                f32x4 go[2], gp[2]; float freq[8];
                go[0] = *(const f32x4*)(gk + 64 + 8 * fqo); go[1] = *(const f32x4*)(gk + 64 + 8 * fqo + 4); gp[0] = *(const f32x4*)(gk + 64 + 8 * (fqo ^ 2)); gp[1] = *(const f32x4*)(gk + 64 + 8 * (fqo ^ 2) + 4);
#pragma unroll
                for (int e = 0; e < 8; ++e) freq[e] = __builtin_amdgcn_exp2f(-(float)(8 * (fqo & 1) + e) * (13.287712379549449f / 16.f));
#pragma unroll
                for (int bj = 0; bj < 2; ++bj) { f32x4 g[2]; g[0] = *(const f32x4*)(gk + 32 * bj + 8 * fqo); g[1] = *(const f32x4*)(gk + 32 * bj + 8 * fqo + 4);
                    const f32x4 a0 = v[bj][0] * rs * g[0], a1 = v[bj][1] * rs * g[1];
                    u32x4 w; w.x = cvtpk(a0[0], a0[1]); w.y = cvtpk(a0[2], a0[3]); w.z = cvtpk(a1[0], a1[1]); w.w = cvtpk(a1[2], a1[3]);
                    *(u32x4*)(rowp + bj * 32) = w; }
                const float fpos = (float)(row & (SEQ - 1)); float y[8];
#pragma unroll
                for (int j = 0; j < 4; ++j) { const unsigned pw = (unsigned)__builtin_amdgcn_ds_bpermute((ln ^ 32) << 2, (int)kr[j]);
#pragma unroll
                    for (int hh = 0; hh < 2; ++hh) { const int e = 2 * j + hh; const float xo = (hh ? bfhi(kr[j]) : bflo(kr[j])) * rs * go[e >> 2][e & 3], xp = (hh ? bfhi(pw) : bflo(pw)) * rs * gp[e >> 2][e & 3];
                        const float ang = fpos * freq[e], nn = rintf(ang * 0.15915494309189535f);
                        float r = fmaf(-nn, 6.28318548202514648f, ang); r = fmaf(-nn, -1.74845553146951715e-7f, r);
                        const float cs = __cosf(r), sn = __sinf(r);
                        y[e] = isx1 ? (xo * cs - xp * sn) : (xo * cs + xp * sn); } }
                u32x4 w2; w2.x = cvtpk(y[0], y[1]); w2.y = cvtpk(y[2], y[3]); w2.z = cvtpk(y[4], y[5]); w2.w = cvtpk(y[6], y[7]);
                *(u32x4*)(rowp + 64) = w2;
                asm volatile("" ::: "memory"); }
    }
};
struct EpiAny {
    int kind; bf16_t* O; int ldc; const float* SS; float invn; const float* base; float* out; bf16_t* xb; float* SSo;
    DI bool perm() const { return true; }
    DI void operator()(const f32x4 (&acc)[2][2][4][2], const Unit& u, int wr, int wc, int fr, int fq) const {
        if (kind == 0) { EpiRow<0> e{O, ldc, SS, invn}; e(acc, u, wr, wc, fr, fq); }
        else if (kind == 1) { EpiRow<1> e{O, ldc, SS, invn}; e(acc, u, wr, wc, fr, fq); }
        else if (kind == 2) { EpiCol e{O, ldc, SS, invn}; e(acc, u, wr, wc, fr, fq); }
        else if (kind == 4) { EpiGN e{O, ldc, SS, base, (const float*)out, SSo}; e(acc, u, wr, wc, fr, fq); }
        else if (kind == 5) { EpiKM e{O, SS, base, (const bf16_t*)out, SSo}; e(acc, u, wr, wc, fr, fq); }
        else { EpiResid e{base, out, xb, (const bf16_t*)SS, O, SSo}; e(acc, u, wr, wc, fr, fq); }
    }
};
template <class Epi>
DI void gemm_phase(LAS unsigned char* lds, const Gemm g, const StaticOrder& S, const Epi& E) {
    int tid_ = threadIdx.x; asm volatile("" : "+v"(tid_));
    const int tid = tid_, wid = __builtin_amdgcn_readfirstlane(tid >> 6), lane = tid & 63, wr = wid >> 2, wc = wid & 3, fr = lane & 15, fq = lane >> 4;
    const int K = g.K, nt = K / BK;
    unsigned voffA[2], voffB[2];
#pragma unroll
    for (int i = 0; i < 2; ++i) { int R, C; stage_rc(tid * 16 + i * 8192, R, C); const int Rb = E.perm() ? ((R & ~31) + perm32(R & 31)) : R;
        voffA[i] = (unsigned)(R * g.lda + C) * 2u; voffB[i] = (unsigned)(Rb * g.ldb + C) * 2u; }
    const size_t kstep = (size_t)(BK * 2);
    const size_t hstepA = (size_t)HALF * g.lda * 2, hstepB = (size_t)HALF * g.ldb * 2;
    const size_t tstepA = 2 * hstepA, tstepB = 2 * hstepB;
    const unsigned ldsw = (unsigned)wid * 1024u;
    const int aoff = lds_byte(wr * 64 + fr, fq * 8), boff = lds_byte(wc * 32 + fr, fq * 8);
#define PG8_SA(b, h) (((b) * 2 + (h)) * HTB)
#define PG8_SB(b, h) ((4 + (b) * 2 + (h)) * HTB)
#define PG8_STAGE(bufoff, gbase, voff) do { _Pragma("unroll") for (int _i = 0; _i < 2; ++_i) \
        __builtin_amdgcn_global_load_lds((const unsigned*)((const char*)(gbase) + (voff)[_i]), (LAS unsigned*)(lds + (bufoff) + ldsw + _i * 8192), 16, 0, 0); } while (0)
#define PG8_LDA(dst, b, h) do { _Pragma("unroll") for (int m = 0; m < 4; ++m) _Pragma("unroll") for (int k = 0; k < 2; ++k) dst[m][k] = *(const LAS bf16x8*)(lds + PG8_SA(b, h) + aoff + m * 2048 + k * 1024); } while (0)
#define PG8_LDB(dst, b, h) do { _Pragma("unroll") for (int n = 0; n < 2; ++n) _Pragma("unroll") for (int k = 0; k < 2; ++k) dst[n][k] = *(const LAS bf16x8*)(lds + PG8_SB(b, h) + boff + n * 2048 + k * 1024); } while (0)
#define PG8_MMA(ai, bj, At, Bt) do { __builtin_amdgcn_s_setprio(1); _Pragma("unroll") for (int m = 0; m < 4; ++m) _Pragma("unroll") for (int n = 0; n < 2; ++n) _Pragma("unroll") for (int k = 0; k < 2; ++k) \
        acc[ai][bj][m][n] = __builtin_amdgcn_mfma_f32_16x16x32_bf16(Bt[n][k], At[m][k], acc[ai][bj][m][n], 0, 0, 0); __builtin_amdgcn_s_setprio(0); } while (0)
#define PG8_WAIT_V(n) asm volatile("s_waitcnt vmcnt(" #n ")" ::: "memory")
#define PG8_WAIT_L(n) asm volatile("s_waitcnt lgkmcnt(" #n ")" ::: "memory")
#define PG8_BAR __builtin_amdgcn_s_barrier()
#define PG8_SCHED __builtin_amdgcn_sched_barrier(0)
    Unit cur, nxt; int ui = 0;
    if (!S.next(0, cur)) return;
    const char* cA = (const char*)g.A + (size_t)cur.pm * tstepA; const char* cB = (const char*)g.Bt + (size_t)cur.pn * tstepB;
    PG8_STAGE(PG8_SB(0, 0), cB, voffB); PG8_STAGE(PG8_SB(0, 1), cB + hstepB, voffB); PG8_STAGE(PG8_SA(0, 0), cA, voffA); PG8_STAGE(PG8_SA(0, 1), cA + hstepA, voffA);
    if (wr == 1) PG8_BAR;
    PG8_WAIT_V(2); PG8_BAR;
    PG8_STAGE(PG8_SB(1, 0), cB + kstep, voffB); PG8_STAGE(PG8_SA(1, 0), cA + kstep, voffA); PG8_STAGE(PG8_SB(1, 1), cB + hstepB + kstep, voffB);
    PG8_WAIT_V(6); PG8_BAR;
    f32x4 acc[2][2][4][2];
#pragma unroll
    for (int a = 0; a < 2; ++a)
#pragma unroll
        for (int b = 0; b < 2; ++b)
#pragma unroll
            for (int m = 0; m < 4; ++m)
#pragma unroll
                for (int n = 0; n < 2; ++n) acc[a][b][m][n] = (f32x4){0.f, 0.f, 0.f, 0.f};
    bf16x8 At[4][2], B0[2][2], B1[2][2];
    for (;;) {
        const bool has_next = S.next(ui + 1, nxt);
        const char* nA = has_next ? (const char*)g.A + (size_t)nxt.pm * tstepA : cA; const char* nB = has_next ? (const char*)g.Bt + (size_t)nxt.pn * tstepB : cB;
        for (int t = 0; t < nt; t += 2) {
            const bool last = (t == nt - 2);
            const char* a1 = cA + (size_t)(t + 1) * kstep;
            const char* a2 = last ? nA : cA + (size_t)(t + 2) * kstep; const char* b2 = last ? nB : cB + (size_t)(t + 2) * kstep;
            const char* a3 = a2 + kstep; const char* b3 = b2 + kstep;
            PG8_LDB(B0, 0, 0); PG8_LDB(B1, 0, 1); PG8_SCHED; PG8_LDA(At, 0, 0); PG8_STAGE(PG8_SA(1, 1), a1 + hstepA, voffA);
            PG8_WAIT_V(8); PG8_WAIT_L(0); PG8_BAR; PG8_MMA(0, 0, At, B0); PG8_MMA(0, 1, At, B1); PG8_BAR; PG8_SCHED;
            PG8_LDA(At, 0, 1); PG8_STAGE(PG8_SB(0, 0), b2, voffB); PG8_STAGE(PG8_SB(0, 1), b2 + hstepB, voffB); PG8_STAGE(PG8_SA(0, 0), a2, voffA);
            PG8_WAIT_V(8); PG8_WAIT_L(0); PG8_BAR; PG8_MMA(1, 0, At, B0); PG8_MMA(1, 1, At, B1); PG8_BAR; PG8_SCHED;
            PG8_LDB(B0, 1, 0); PG8_LDB(B1, 1, 1); PG8_SCHED; PG8_LDA(At, 1, 0); PG8_STAGE(PG8_SA(0, 1), a2 + hstepA, voffA);
            PG8_WAIT_V(8); PG8_WAIT_L(0); PG8_BAR; PG8_MMA(0, 0, At, B0); PG8_MMA(0, 1, At, B1); PG8_BAR; PG8_SCHED;
            PG8_LDA(At, 1, 1); PG8_STAGE(PG8_SB(1, 0), b3, voffB); PG8_STAGE(PG8_SB(1, 1), b3 + hstepB, voffB); PG8_STAGE(PG8_SA(1, 0), a3, voffA);
            PG8_WAIT_V(8); PG8_WAIT_L(0); PG8_BAR; PG8_MMA(1, 0, At, B0); PG8_MMA(1, 1, At, B1); PG8_BAR; PG8_SCHED;
        }
        if (wr == 0) PG8_BAR;
        E(acc, cur, wr, wc, fr, fq);
        if (!has_next) break;
#pragma unroll
        for (int a = 0; a < 2; ++a)
#pragma unroll
            for (int b = 0; b < 2; ++b)
#pragma unroll
                for (int m = 0; m < 4; ++m)
#pragma unroll
                    for (int n = 0; n < 2; ++n) acc[a][b][m][n] = (f32x4){0.f, 0.f, 0.f, 0.f};
        cur = nxt; cA = nA; cB = nB; ++ui;
        if (wr == 1) PG8_BAR;
    }
    PG8_WAIT_V(0);
    PG8_BAR;
#undef PG8_SA
#undef PG8_SB
#undef PG8_STAGE
#undef PG8_LDA
#undef PG8_LDB
#undef PG8_MMA
#undef PG8_WAIT_V
#undef PG8_WAIT_L
#undef PG8_BAR
#undef PG8_SCHED
}
}

namespace at {
constexpr int KB0 = 0, KB1 = 17408, VB0 = 34816, VBSZ = 17408, TBL = 87040, FLG = 89600, VSTR = 136;
#define MFMA32(a, b, c) __builtin_amdgcn_mfma_f32_32x32x16_bf16((a), (b), (c), 0, 0, 0)
DI float ex2(float x) { return __builtin_amdgcn_exp2f(x); }
DI float lg2(float x) { return __builtin_amdgcn_logf(x); }

template <int MODE> struct Cfg;
template <> struct Cfg<0> { static constexpr int DQK = 64, KW = 256, DV = 128, ROWS = 128; };
template <> struct Cfg<1> { static constexpr int DQK = 96, KW = 192, DV = 64, ROWS = 256; };
template <> struct Cfg<2> { static constexpr int DQK = 64, KW = 256, DV = 128, ROWS = 128; };
template <> struct Cfg<3> { static constexpr int DQK = 64, KW = 128, DV = 64, ROWS = 256; };

DI void sb_prep(f32x16& P, f32x16& L, int kb, int qrow, bool diag) {
#pragma unroll
    for (int i = 0; i < 16; ++i) {
        const float z = P[i], e = ex2(-fabsf(z)), sp = fmaxf(z, 0.f) + lg2(1.f + e);
        float l = -sp, lb = z - sp;
        if (diag) { const int key = kb + (i & 3) + 8 * (i >> 2); if (key >= qrow) { l = 0.f; lb = -1e30f; } }
        L[i] = l; P[i] = lb;
    }
}

template <int MODE>
DI void attn_unit(LAS unsigned char* lds, const bf16_t* Qg, int ldq, const bf16_t* Kg, int ldk, const bf16_t* VTg, int ldvt, bf16_t* Og, int ldo,
                  int q0, int NT, const float* gout, const float* relb, float lam, float osc, const float* qgain) {
    typedef Cfg<MODE> C;
    constexpr int NS = C::DQK / 16, KSTR = C::KW + 16, KCH = C::KW / 16, NKCH = 64 * KCH, KJ = (NKCH + 511) / 512, NVCH = C::DV * 8, VJ = NVCH / 512, NDB = (MODE == 2) ? 2 : C::DV / 32;
    int tid_ = threadIdx.x; asm volatile("" : "+v"(tid_));
    const int tid = tid_, lane = tid & 63, wid = __builtin_amdgcn_readfirstlane(tid >> 6), r32 = lane & 31, hi = lane >> 5;
    const int rg = (MODE == 0 || MODE == 2) ? (wid & 3) : wid, mm = (MODE == 0 || MODE == 2) ? (wid >> 2) : 0;
    const int qrow = q0 + 32 * rg + r32;
    int ntw = NT, TD = 0;
    if (MODE == 0 || MODE == 1) ntw = (q0 + 32 * rg) / 64 + 1;
    if (MODE == 2) TD = (q0 + 32 * rg + 31) / 64;

    bf16x8 qf[NS];
    {
        const bf16_t* qp = Qg + (size_t)qrow * ldq + mm * 64 + 8 * hi;
#pragma unroll
        for (int s = 0; s < NS; ++s) qf[s] = *(const bf16x8*)(qp + 16 * s);
        if (MODE == 1) {
            float ss = 0.f; float f[NS][8];
#pragma unroll
            for (int s = 0; s < NS; ++s) { const u32x4 w = __builtin_bit_cast(u32x4, qf[s]);
#pragma unroll
                for (int j = 0; j < 4; ++j) { f[s][2 * j] = bflo(w[j]); f[s][2 * j + 1] = bfhi(w[j]); ss += f[s][2 * j] * f[s][2 * j] + f[s][2 * j + 1] * f[s][2 * j + 1]; } }
            ss += shx(ss, 32, lane);
            const float rs = rsqrtf(ss * (1.f / 96.f) + EPS);
#pragma unroll
            for (int s = 0; s < NS; ++s) { const float* gp = qgain + 16 * s + 8 * hi;
#pragma unroll
                for (int j = 0; j < 8; ++j) f[s][j] *= rs * gp[j]; }
            const float fpos = (float)qrow;
#pragma unroll
            for (int j = 0; j < 8; ++j) {
                const float freq = __builtin_amdgcn_exp2f(-(float)(8 * hi + j) * (13.287712379549449f / 16.f));
                const float ang = fpos * freq, n = rintf(ang * 0.15915494309189535f);
                float r = fmaf(-n, 6.28318548202514648f, ang); r = fmaf(-n, -1.74845553146951715e-7f, r);
                const float cs = __cosf(r), sn = __sinf(r), x1 = f[4][j], x2 = f[5][j];
                f[4][j] = x1 * cs - x2 * sn; f[5][j] = x2 * cs + x1 * sn;
            }
#pragma unroll
            for (int s = 0; s < NS; ++s) { u32x4 w;
#pragma unroll
                for (int j = 0; j < 4; ++j) w[j] = cvtpk(f[s][2 * j] * QS96, f[s][2 * j + 1] * QS96);
                qf[s] = __builtin_bit_cast(bf16x8, w); }
        }
        if (MODE == 3) {
            float ss = 0.f; float f[NS][8];
#pragma unroll
            for (int s = 0; s < NS; ++s) { const u32x4 w = __builtin_bit_cast(u32x4, qf[s]);
#pragma unroll
                for (int j = 0; j < 4; ++j) { f[s][2 * j] = bflo(w[j]); f[s][2 * j + 1] = bfhi(w[j]); ss += f[s][2 * j] * f[s][2 * j] + f[s][2 * j + 1] * f[s][2 * j + 1]; } }
            ss += shx(ss, 32, lane);
            const float rs = rsqrtf(ss * (1.f / 64.f) + EPS) * QS64;
#pragma unroll
            for (int s = 0; s < NS; ++s) { const float* gp = qgain + 16 * s + 8 * hi; u32x4 w;
#pragma unroll
                for (int j = 0; j < 4; ++j) w[j] = cvtpk(f[s][2 * j] * rs * gp[2 * j], f[s][2 * j + 1] * rs * gp[2 * j + 1]);
                qf[s] = __builtin_bit_cast(bf16x8, w); }
        }
    }
    float c15 = 0.f;
    if (MODE == 0) {
        LAS float* tb = (LAS float*)(lds + TBL);
        for (int idx = tid; idx < 640; idx += 512) { const int m2 = idx / 320, rel = (idx % 320) - 256; const int n = rel < 0 ? -rel : rel;
            int bk = rel > 0 ? 16 : 0; if (n < 8) bk += n; else { int lg = (31 - __clz(n * n)) + 2; bk += lg > 15 ? 15 : lg; }
            tb[idx] = (relb[bk * 8 + m2] - relb[15 * 8 + m2]) * LOG2E; }
        c15 = relb[15 * 8 + mm] * LOG2E;
    }
    u32x4 kr[KJ], vr[VJ];
#define AT_GLOAD(key0) do { _Pragma("unroll") for (int j = 0; j < KJ; ++j) { const int idx = tid + 512 * j; if (idx < NKCH) { const int row = idx / KCH, c = idx % KCH; \
            kr[j] = *(const u32x4*)(Kg + (size_t)((key0) + row) * ldk + c * 8); } } \
        _Pragma("unroll") for (int j = 0; j < VJ; ++j) { const int idx = tid + 512 * j; const int row = idx >> 3, c = idx & 7; vr[j] = *(const u32x4*)(VTg + (size_t)row * ldvt + (key0) + c * 8); } } while (0)
#define AT_LSTORE(buf, vbi) do { _Pragma("unroll") for (int j = 0; j < KJ; ++j) { const int idx = tid + 512 * j; if (idx < NKCH) { const int row = idx / KCH, c = idx % KCH; \
            *(LAS u32x4*)(lds + ((buf) ? KB1 : KB0) + row * KSTR + c * 16) = kr[j]; } } \
        _Pragma("unroll") for (int j = 0; j < VJ; ++j) { const int idx = tid + 512 * j; const int row = idx >> 3, c = idx & 7; LAS unsigned char* p = lds + VB0 + (vbi) * VBSZ + row * VSTR + c * 16; \
            *(LAS u32x2*)p = (u32x2){vr[j].x, vr[j].y}; *(LAS u32x2*)(p + 8) = (u32x2){vr[j].z, vr[j].w}; } } while (0)
#define AT_KEY0(t) ((MODE == 2) ? 64 * (NT - 1 - (t)) : 64 * (t))
    AT_GLOAD(AT_KEY0(0)); AT_LSTORE(0, 0);
    __syncthreads();

    float mhat = 0.f, lrun = 0.f, R = 0.f;
    f32x16 negm;
#pragma unroll
    for (int i = 0; i < 16; ++i) negm[i] = c15;
    f32x16 o[NDB];
#pragma unroll
    for (int d = 0; d < NDB; ++d)
#pragma unroll
        for (int i = 0; i < 16; ++i) o[d][i] = 0.f;

    const bool skew = (MODE != 2) && (wid >= 4);
    u32x4 pk[4];
#pragma unroll
    for (int j = 0; j < 4; ++j) pk[j] = (u32x4){0u, 0u, 0u, 0u};
    auto pvdo = [&](const int vbi, const u32x4 (&pp)[4]) {
        const LAS unsigned char* Vb = lds + VB0 + vbi * VBSZ + (r32 + (MODE == 2 ? mm * 64 : 0)) * VSTR + hi * 8;
#pragma unroll
        for (int d = 0; d < NDB; ++d)
#pragma unroll
            for (int ks = 0; ks < 4; ++ks) { const int kb = 32 * (ks >> 1) + 16 * (ks & 1);
                const s16x4 lo = *(const LAS s16x4*)(Vb + d * 32 * VSTR + kb * 2), hh = *(const LAS s16x4*)(Vb + d * 32 * VSTR + kb * 2 + 16);
                const bf16x8 vf = __builtin_shufflevector(lo, hh, 0, 1, 2, 3, 4, 5, 6, 7);
                o[d] = MFMA32(vf, __builtin_bit_cast(bf16x8, pp[ks]), o[d]); }
    };
    int vcur = 0;
    for (int t = 0; t < NT; ++t) {
        const int cur = t & 1;
        const int vnext = vcur == 2 ? 0 : vcur + 1, vprev = vcur == 0 ? 2 : vcur - 1;
        if (MODE == 2 && SB_EARLY && t > 0) {
            const LAS unsigned* fl = (const LAS unsigned*)(lds + FLG) + ((t - 1) & 1) * 8; unsigned any = 0;
#pragma unroll
            for (int w = 0; w < 8; ++w) any |= fl[w];
            if (any == 0u) break;
        }
        if (t + 1 < NT) AT_GLOAD(AT_KEY0(t + 1));
        const int key0 = AT_KEY0(t);
        bool active;
        if (MODE == 2) active = (NT - 1 - t) <= TD; else active = t < ntw;
        bool alive = true;
        if (MODE == 2) alive = !active || __any(R > -150.f);
        if (skew && t >= 1 && (t - 1) < ntw) pvdo(vprev, pk);
        if (active && alive) {
            const LAS unsigned char* Kb = lds + (cur ? KB1 : KB0) + r32 * KSTR + mm * 128 + hi * 16;
            f32x16 p0, p1;
#pragma unroll
            for (int s = 0; s < NS; ++s) { const bf16x8 a0 = *(const LAS bf16x8*)(Kb + s * 32), a1 = *(const LAS bf16x8*)(Kb + 32 * KSTR + s * 32);
                if (s == 0) { p0 = MFMA32(a0, qf[0], negm); p1 = MFMA32(a1, qf[0], negm); } else { p0 = MFMA32(a0, qf[s], p0); p1 = MFMA32(a1, qf[s], p1); } }
            if (MODE != 2) {
                if (MODE == 0) {
                    const int qmin = q0 + 32 * rg;
                    if (key0 + 63 - qmin > -128) {
                        const LAS float* tb = (const LAS float*)(lds + TBL) + mm * 320 + (key0 - qrow + 256 + 4 * hi);
#pragma unroll
                        for (int i = 0; i < 16; ++i) { p0[i] += tb[(i & 3) + 8 * (i >> 2)]; p1[i] += tb[32 + (i & 3) + 8 * (i >> 2)]; }
                    }
                }
                float mx = __builtin_fmaxf(__builtin_fmaxf(p0[0], p0[1]), p0[2]);
#pragma unroll
                for (int i = 3; i < 15; i += 2) mx = __builtin_fmaxf(__builtin_fmaxf(mx, p0[i]), p0[i + 1]);
                mx = __builtin_fmaxf(mx, p0[15]);
#pragma unroll
                for (int i = 0; i < 16; i += 2) mx = __builtin_fmaxf(__builtin_fmaxf(mx, p1[i]), p1[i + 1]);
                mx = __builtin_fmaxf(mx, shx(mx, 32, lane));
                if (t == 0 || __any(mx > 8.f)) {
                    const float dl = (t == 0) ? mx : __builtin_fmaxf(mx, 0.f);
                    mhat += dl;
#pragma unroll
                    for (int i = 0; i < 16; ++i) { p0[i] -= dl; p1[i] -= dl; }
#pragma unroll
                    for (int i = 0; i < 16; ++i) negm[i] = c15 - mhat;
                    if (t > 0) { const float f = ex2(-dl); lrun *= f;
#pragma unroll
                        for (int d = 0; d < NDB; ++d)
#pragma unroll
                            for (int i = 0; i < 16; ++i) o[d][i] *= f; }
                }
                float rs = 0.f;
#pragma unroll
                for (int i = 0; i < 16; ++i) { p0[i] = ex2(p0[i]); p1[i] = ex2(p1[i]); rs += p0[i] + p1[i]; }
                lrun += rs;
            } else {
                f32x16 L0, L1;
                const bool diag = (NT - 1 - t) == TD;
                sb_prep(p0, L0, key0 + 4 * hi, qrow, diag); sb_prep(p1, L1, key0 + 32 + 4 * hi, qrow, diag);
                float own[8], par[8];
#pragma unroll
                for (int g = 0; g < 4; ++g) { own[g] = (L0[4 * g] + L0[4 * g + 1]) + (L0[4 * g + 2] + L0[4 * g + 3]); own[4 + g] = (L1[4 * g] + L1[4 * g + 1]) + (L1[4 * g + 2] + L1[4 * g + 3]); }
#pragma unroll
                for (int g = 0; g < 8; ++g) par[g] = shx(own[g], 32, lane);
                float so = 0.f, sp2 = 0.f;
#pragma unroll
                for (int g = 7; g >= 0; --g) {
                    const float SG = R + so + sp2 + (hi == 0 ? par[g] : 0.f);
                    float w = 0.f;
#pragma unroll
                    for (int e = 3; e >= 0; --e) { const int idx = 4 * (g & 3) + e;
                        if (g >= 4) { p1[idx] = ex2(p1[idx] + SG + w); w += L1[idx]; } else { p0[idx] = ex2(p0[idx] + SG + w); w += L0[idx]; } }
                    so += own[g]; sp2 += par[g];
                }
                R += so + sp2;
            }
#pragma unroll
            for (int j = 0; j < 4; ++j) { pk[0][j] = cvtpk(p0[2 * j], p0[2 * j + 1]); pk[1][j] = cvtpk(p0[8 + 2 * j], p0[8 + 2 * j + 1]);
                pk[2][j] = cvtpk(p1[2 * j], p1[2 * j + 1]); pk[3][j] = cvtpk(p1[8 + 2 * j], p1[8 + 2 * j + 1]); }
            if (!skew) pvdo(vcur, pk);
        }
        if (MODE == 2 && SB_EARLY) { if (lane == 0) ((LAS unsigned*)(lds + FLG))[cur * 8 + wid] = (!active || __any(R > -150.f)) ? 1u : 0u; }
        if (t + 1 < NT) AT_LSTORE(cur ^ 1, vnext);
        __syncthreads();
        vcur = vnext;
    }
    if (MODE != 2) {
        if (skew && ntw == NT) pvdo((NT - 1) % 3, pk);
        __syncthreads();
    }
#undef AT_GLOAD
#undef AT_LSTORE
#undef AT_KEY0
#define AT_STORE16(OPB, D) do { _Pragma("unroll") for (int k2 = 0; k2 < 2; ++k2) { const u32x2 snd = hi ? wq[2 * k2] : wq[2 * k2 + 1]; \
        const unsigned r0 = (unsigned)__builtin_amdgcn_ds_bpermute((lane ^ 32) << 2, (int)snd.x), r1 = (unsigned)__builtin_amdgcn_ds_bpermute((lane ^ 32) << 2, (int)snd.y); \
        const u32x4 ov = hi ? (u32x4){r0, r1, wq[2 * k2 + 1].x, wq[2 * k2 + 1].y} : (u32x4){wq[2 * k2].x, wq[2 * k2].y, r0, r1}; \
        *(u32x4*)((OPB) + 32 * (D) + 16 * k2 + 8 * hi) = ov; } } while (0)
    float inv = 1.f;
    if (MODE != 2) { const float lt = lrun + shx(lrun, 32, lane); inv = 1.f / lt; }
    if (MODE == 0) {
        LAS float* X = (LAS float*)lds;
        if (mm == 1) {
#pragma unroll
            for (int d = 0; d < NDB; ++d)
#pragma unroll
                for (int i = 0; i < 16; ++i) X[(rg * 64 + d * 16 + i) * 64 + lane] = o[d][i] * inv;
        }
        __syncthreads();
        if (mm == 0) {
            float ss = 0.f;
#pragma unroll
            for (int d = 0; d < NDB; ++d)
#pragma unroll
                for (int i = 0; i < 16; ++i) { const float v = o[d][i] * inv - lam * X[(rg * 64 + d * 16 + i) * 64 + lane]; o[d][i] = v; ss += v * v; }
            ss += shx(ss, 32, lane);
            const float rs = rsqrtf(ss * (1.f / 128.f) + EPS) * osc;
            bf16_t* opb = Og + (size_t)qrow * ldo;
#pragma unroll
            for (int d = 0; d < NDB; ++d) { u32x2 wq[4];
#pragma unroll
                for (int g = 0; g < 4; ++g) { const f32x4 gv = *(const f32x4*)(gout + 32 * d + 8 * g + 4 * hi);
                    u32x2 w; w.x = cvtpk(o[d][4 * g] * rs * gv[0], o[d][4 * g + 1] * rs * gv[1]); w.y = cvtpk(o[d][4 * g + 2] * rs * gv[2], o[d][4 * g + 3] * rs * gv[3]);
                    wq[g] = w; }
                AT_STORE16(opb, d); }
        }
        __syncthreads();
    } else {
        float rs = inv;
        if (MODE == 1 || MODE == 2) {
            float ss = 0.f;
#pragma unroll
            for (int d = 0; d < NDB; ++d)
#pragma unroll
                for (int i = 0; i < 16; ++i) { const float v = o[d][i] * inv; ss += v * v; }
            ss += shx(ss, 32, lane);
            rs = inv * rsqrtf(ss * (1.f / 64.f) + EPS);
        }
        bf16_t* opb = Og + (size_t)qrow * ldo + (MODE == 2 ? mm * 64 : 0);
#pragma unroll
        for (int d = 0; d < NDB; ++d) { u32x2 wq[4];
#pragma unroll
            for (int g = 0; g < 4; ++g) { f32x4 gv = (f32x4){1.f, 1.f, 1.f, 1.f}; if (MODE != 3) gv = *(const f32x4*)(gout + 32 * d + 8 * g + 4 * hi);
                u32x2 w; w.x = cvtpk(o[d][4 * g] * rs * gv[0], o[d][4 * g + 1] * rs * gv[1]); w.y = cvtpk(o[d][4 * g + 2] * rs * gv[2], o[d][4 * g + 3] * rs * gv[3]);
                wq[g] = w; }
            AT_STORE16(opb, d); }
    }
#undef AT_STORE16
}
}

DI float wave_sum(float v, int lane) {
#pragma unroll
    for (int o = 1; o < 64; o <<= 1) v += shx(v, o, lane);
    return v;
}
DI void transpose_item(const float* W, int ldw, int c0, int nc, int K, const float* g, float scale, bf16_t* WT, LAS float* scr, int item, int lane, int gperm, int nbase) {
    const int nblk = nc / 32, kb = item / nblk, nb = item % nblk, k0 = 64 * kb, n0 = 32 * nb;
    float wv[32];
#pragma unroll
    for (int i = 0; i < 32; ++i) { const int kk = 2 * i + (lane >> 5); wv[i] = W[(size_t)(k0 + kk) * ldw + c0 + n0 + (lane & 31)]; }
    const float gl = g ? g[k0 + lane] * scale : scale;
#pragma unroll
    for (int i = 0; i < 32; ++i) { const int kk = 2 * i + (lane >> 5); const float gg = __builtin_bit_cast(float, __builtin_amdgcn_ds_bpermute(kk << 2, __builtin_bit_cast(int, gl)));
        scr[kk * 33 + (lane & 31)] = wv[i] * gg; }
    asm volatile("s_waitcnt lgkmcnt(0)" ::: "memory");
    const int c = lane & 7;
    const int n0g = nbase + n0;
    const int prow0 = gperm ? (n0g & ~255) + ((n0g & 32) ? 128 : 0) + 32 * ((n0g >> 6) & 3) : n0;
#pragma unroll
    for (int j = 0; j < 4; ++j) { const int n = (lane >> 3) + 8 * j; const LAS float* s = scr + (8 * c) * 33 + n;
        u32x4 o; o.x = cvtpk(s[0 * 33], s[1 * 33]); o.y = cvtpk(s[2 * 33], s[3 * 33]); o.z = cvtpk(s[4 * 33], s[5 * 33]); o.w = cvtpk(s[6 * 33], s[7 * 33]);
        *(u32x4*)(WT + (size_t)(prow0 + n) * K + k0 + 8 * c) = o; }
    asm volatile("s_waitcnt lgkmcnt(0)" ::: "memory");
}
struct Seg { const float* W; int ldw, c0, nc, K; const float* g; float scale; bf16_t* dst; int gperm, nbase; };
DI Seg get_seg(const Args& a, int l, int s) {
    unsigned char* wl = a.ws + WS_W + (size_t)l * WL_STRIDE;
    Seg r; r.g = nullptr; r.scale = 1.f; r.gperm = 0; r.nbase = 0;
    const float* w_in = a.in[4] + (size_t)l * 1024 * 2720; const float* gmix = a.in[3] + l * 1024;
    bf16_t* win = (bf16_t*)(wl + WL_IN);
    if (s < 6) { r.W = w_in; r.ldw = 2720; r.K = 1024; r.g = gmix;
        if (s == 0) { r.c0 = 0; r.nc = 1024; r.dst = win; r.gperm = 1; }
        else if (s == 1) { r.c0 = 1536; r.nc = 256; r.dst = win + 1024 * 1024; r.scale = QS64; }
        else if (s == 2) { r.c0 = 1792; r.nc = 256; r.dst = win + 1280 * 1024; }
        else if (s == 3) { r.c0 = 2304; r.nc = 416; r.dst = win + 1536 * 1024; }
        else if (s == 4) { r.c0 = 1024; r.nc = 512; r.dst = win + 2048 * 1024; }
        else { r.c0 = 2048; r.nc = 256; r.dst = win + 2560 * 1024; }
    } else if (s == 6) { r.W = a.in[12] + (size_t)l * 256 * 384; r.ldw = 384; r.c0 = 0; r.nc = 384; r.K = 256; r.g = a.in[10] + l * 256; r.dst = (bf16_t*)(wl + WL_UQ); }
    else if (s < 15) { const int h = (s - 7) & 3, isv = (s - 7) >> 2; r.W = a.in[13] + (size_t)l * 128 * 512; r.ldw = 512; r.c0 = h * 128 + isv * 64; r.nc = 64; r.K = 128; r.g = a.in[11] + l * 128;
        r.dst = (bf16_t*)(wl + (isv ? WL_UV : WL_UK)) + (isv ? h * 64 * 128 : 0); if (!isv) { r.gperm = 1; r.nbase = h * 64; } }
    else if (s == 15) { r.W = a.in[17] + (size_t)l * 1024 * 1024; r.ldw = 1024; r.c0 = 0; r.nc = 1024; r.K = 1024; r.dst = (bf16_t*)(wl + WL_OUT); }
    else if (s == 16) { r.W = a.in[20] + (size_t)l * 1024 * 256; r.ldw = 256; r.c0 = 0; r.nc = 256; r.K = 1024; r.g = a.in[18] + l * 1024; r.dst = (bf16_t*)(wl + WL_MQ); }
    else if (s == 17) { r.W = a.in[21] + (size_t)l * 1024 * 512; r.ldw = 512; r.c0 = 0; r.nc = 512; r.K = 1024; r.g = a.in[19] + l * 1024; r.dst = (bf16_t*)(wl + WL_MKV); }
    else if (s == 18) { r.W = a.in[24] + (size_t)l * 256 * 1024; r.ldw = 1024; r.c0 = 0; r.nc = 1024; r.K = 256; r.dst = (bf16_t*)(wl + WL_MO); }
    else if (s == 19) { r.W = a.in[26] + (size_t)l * 1024 * 4096; r.ldw = 4096; r.c0 = 0; r.nc = 4096; r.K = 1024; r.g = a.in[25] + l * 1024; r.dst = (bf16_t*)(wl + WL_F1); }
    else { r.W = a.in[27] + (size_t)l * 4096 * 1024; r.ldw = 1024; r.c0 = 0; r.nc = 1024; r.K = 4096; r.dst = (bf16_t*)(wl + WL_F2); }
    return r;
}
DI void row_to_bf16(const float* xrow, bf16_t* orow, float* rs, int lane) {
    const f32x4* xr = (const f32x4*)xrow + lane; f32x4 v[4]; float s = 0.f;
#pragma unroll
    for (int j = 0; j < 4; ++j) { v[j] = xr[64 * j]; s += (v[j].x * v[j].x + v[j].y * v[j].y) + (v[j].z * v[j].z + v[j].w * v[j].w); }
    s = wave_sum(s, lane);
    u32x2* o8 = (u32x2*)orow + lane;
#pragma unroll
    for (int j = 0; j < 4; ++j) { u32x2 w; w.x = cvtpk(v[j].x, v[j].y); w.y = cvtpk(v[j].z, v[j].w); o8[64 * j] = w; }
    if (lane == 0) *rs = rsqrtf(s * (1.f / 1024.f) + EPS);
}
DI void prologue_phase(const Args& a, LAS unsigned char* lds, int gw, int NGW, int wave, int lane) {
    LAS float* scr = (LAS float*)(lds + wave * 16384);
    int rot = 0;
    for (int l = 0; l < DEPTH; ++l) {
        for (int s = 0; s < 21; ++s) { const Seg sg = get_seg(a, l, s); const int items = (sg.K / 64) * (sg.nc / 32);
            int first = gw - rot; if (first < 0) first += NGW;
            for (int it = first; it < items; it += NGW) transpose_item(sg.W, sg.ldw, sg.c0, sg.nc, sg.K, sg.g, sg.scale, sg.dst, scr, it, lane, sg.gperm, sg.nbase);
            rot = (rot + items) % NGW; }
        unsigned char* wl = a.ws + WS_W + (size_t)l * WL_STRIDE;
        u32x4* z1 = (u32x4*)(wl + WL_IN + (size_t)1952 * 1024 * 2); u32x4* z2 = (u32x4*)(wl + WL_UQ + (size_t)384 * 256 * 2);
        const u32x4 zz = (u32x4){0u, 0u, 0u, 0u};
        for (int i = gw * 64 + lane; i < 96 * 1024 * 2 / 16; i += NGW * 64) z1[i] = zz;
        for (int i = gw * 64 + lane; i < 128 * 256 * 2 / 16; i += NGW * 64) z2[i] = zz;
    }
    bf16_t* XB = (bf16_t*)(a.ws + WS_XB); float* RS = (float*)(a.ws + WS_RSTD);
    for (int m0 = gw * 4; m0 < MT; m0 += NGW * 4) {
        f32x4 v[4][4]; float sq[4];
#pragma unroll
        for (int u = 0; u < 4; ++u) { const f32x4* xr = (const f32x4*)(a.in[0] + (size_t)(m0 + u) * DM) + lane; sq[u] = 0.f;
#pragma unroll
            for (int j = 0; j < 4; ++j) v[u][j] = __builtin_nontemporal_load(xr + 64 * j); }
#pragma unroll
        for (int u = 0; u < 4; ++u) {
#pragma unroll
            for (int j = 0; j < 4; ++j) sq[u] += (v[u][j].x * v[u][j].x + v[u][j].y * v[u][j].y) + (v[u][j].z * v[u][j].z + v[u][j].w * v[u][j].w); }
#pragma unroll
        for (int o = 1; o < 64; o <<= 1) {
#pragma unroll
            for (int u = 0; u < 4; ++u) sq[u] += shx(sq[u], o, lane); }
#pragma unroll
        for (int u = 0; u < 4; ++u) { u32x2* o8 = (u32x2*)(XB + (size_t)(m0 + u) * DM) + lane;
            u32x2* l8 = (u32x2*)((bf16_t*)a.out + (size_t)(m0 + u) * DM) + lane;
#pragma unroll
            for (int j = 0; j < 4; ++j) { u32x2 w; w.x = cvtpk(v[u][j].x, v[u][j].y); w.y = cvtpk(v[u][j].z, v[u][j].w); o8[64 * j] = w;
                u32x2 wl; wl.x = cvtpk(v[u][j].x - bflo(w.x), v[u][j].y - bfhi(w.x)); wl.y = cvtpk(v[u][j].z - bflo(w.y), v[u][j].w - bfhi(w.y)); l8[64 * j] = wl; }
            if (lane == 0) RS[m0 + u] = rsqrtf(sq[u] * (1.f / 1024.f) + EPS); }
    }
    bf16_t* MB = (bf16_t*)(a.ws + WS_MEMB); float* SM = (float*)(a.ws + WS_RSTDM);
    for (int m = gw; m < MROWS; m += NGW) row_to_bf16(a.in[1] + (size_t)m * DM, MB + (size_t)m * DM, SM + m, lane);
}
DI void norm8(u32x4& v, const float* g8, float extra, float invn, int xmask, int lane) {
    float f[8];
#pragma unroll
    for (int j = 0; j < 4; ++j) { f[2 * j] = bflo(v[j]); f[2 * j + 1] = bfhi(v[j]); }
    float ss = 0.f;
#pragma unroll
    for (int j = 0; j < 8; ++j) ss += f[j] * f[j];
#pragma unroll
    for (int o = 1; o <= xmask; o <<= 1) ss += shx(ss, o, lane);
    const float rs = rsqrtf(ss * invn + EPS) * extra;
#pragma unroll
    for (int j = 0; j < 4; ++j) v[j] = cvtpk(f[2 * j] * rs * g8[2 * j], f[2 * j + 1] * rs * g8[2 * j + 1]);
}
DI void post1_phase(const Args& a, int l, int gw, int NGW, int lane) {
    bf16_t* PROJ = (bf16_t*)(a.ws + WS_PROJ);
    const float* gq = a.in[5] + l * 64; const float* gk = a.in[6] + l * 64; const float* gcq = a.in[10] + l * 256; const float* gckv = a.in[11] + l * 128;
    const bool act = lane < 48; const int col3 = lane < 32 ? 1536 + 8 * lane : 1792 + 8 * ((lane - 32) & 15);
    const float* g3 = lane < 32 ? gcq + 8 * lane : gckv + 8 * ((lane - 32) & 15);
    for (int tok0 = gw * 4; tok0 < MT; tok0 += NGW * 4) {
        u32x4 v[4];
#pragma unroll
        for (int u = 0; u < 4; ++u) v[u] = *(const u32x4*)(PROJ + (size_t)(tok0 + u) * LDP + col3);
#pragma unroll
        for (int u = 0; u < 4; ++u) {
            float f[8];
#pragma unroll
            for (int j = 0; j < 4; ++j) { f[2 * j] = bflo(v[u][j]); f[2 * j + 1] = bfhi(v[u][j]); }
            float ss = 0.f;
#pragma unroll
            for (int j = 0; j < 8; ++j) ss += f[j] * f[j];
            if (!act) ss = 0.f;
            ss += shx(ss, 1, lane); ss += shx(ss, 2, lane); ss += shx(ss, 4, lane); ss += shx(ss, 8, lane);
            const float s32 = ss + shx(ss, 16, lane);
            const float rs = lane < 32 ? rsqrtf(s32 * (1.f / 256.f) + EPS) : rsqrtf(ss * (1.f / 128.f) + EPS);
#pragma unroll
            for (int j = 0; j < 4; ++j) v[u][j] = cvtpk(f[2 * j] * rs * g3[2 * j], f[2 * j + 1] * rs * g3[2 * j + 1]);
        }
#pragma unroll
        for (int u = 0; u < 4; ++u) if (act) *(u32x4*)(PROJ + (size_t)(tok0 + u) * LDP + col3) = v[u];
    }
}
DI void memk_phase(const Args& a, int gw, int NGW, int lane) {
    for (int l = 0; l < DEPTH; ++l) { bf16_t* KM = (bf16_t*)(a.ws + WS_KMEM) + (size_t)l * MROWS * 256; const float* g = a.in[23] + l * 64;
        for (int r2 = gw; r2 < MROWS / 2; r2 += NGW) { bf16_t* p = KM + (size_t)(2 * r2 + (lane >> 5)) * 256 + 8 * (lane & 31);
            u32x4 v = *(const u32x4*)p; norm8(v, g + (lane & 7) * 8, 1.f, 1.f / 64.f, 4, lane); *(u32x4*)p = v; } }
}
DI void post2_phase(const Args& a, int l, int gw, int NGW, int lane) {
    bf16_t* QM = (bf16_t*)(a.ws + WS_QM); bf16_t* KN = (bf16_t*)(a.ws + WS_KN); bf16_t* KM = (bf16_t*)(a.ws + WS_KM); bf16_t* PROJ = (bf16_t*)(a.ws + WS_PROJ);
    const float* gq = a.in[14] + l * 96; const float* gk = a.in[15] + l * 96;
    const bool act = lane < 48; const int ln = act ? lane : 47, h = ln / 12, c = ln - 12 * h;
    const bool isrope = c >= 8, isx1 = (c == 8 || c == 9); const int base12 = 12 * h;
    float freq[8];
#pragma unroll
    for (int e = 0; e < 8; ++e) freq[e] = __builtin_amdgcn_exp2f(-(float)(8 * (c & 1) + e) * (13.287712379549449f / 16.f));
    float gqo[8], gqp[8], gko[8], gkp[8];
    const int cp = isrope ? (isx1 ? c + 2 : c - 2) : c;
#pragma unroll
    for (int e = 0; e < 8; ++e) { gqo[e] = gq[8 * c + e]; gqp[e] = gq[8 * cp + e]; gko[e] = gk[8 * c + e]; gkp[e] = gk[8 * cp + e]; }
    const int plane = isrope ? (isx1 ? lane + 2 : lane - 2) : lane;
    for (int it0 = gw * 4; it0 < MT; it0 += NGW * 4) {
        u32x4 v[4];
#pragma unroll
        for (int u = 0; u < 4; ++u) { const int isk = 1, tok = it0 + u;
            const bf16_t* src = !isk ? QM + (size_t)tok * 512 + h * 96 + 8 * c : (c < 8 ? KN + (size_t)tok * 256 + h * 64 + 8 * c : PROJ + (size_t)tok * LDP + 1920 + 8 * (c - 8));
            v[u] = *(const u32x4*)src; }
#pragma unroll
        for (int u = 0; u < 4; ++u) { const int isk = 1, tok = it0 + u, pos = tok & (SEQ - 1);
            float f[8], pf[8];
#pragma unroll
            for (int j = 0; j < 4; ++j) { f[2 * j] = bflo(v[u][j]); f[2 * j + 1] = bfhi(v[u][j]); }
            float ss = 0.f;
#pragma unroll
            for (int j = 0; j < 8; ++j) ss += f[j] * f[j];
            ss += shx(ss, 1, lane); ss += shx(ss, 2, lane);
            const float t0 = __builtin_bit_cast(float, __builtin_amdgcn_ds_bpermute((base12) << 2, __builtin_bit_cast(int, ss)));
            const float t1 = __builtin_bit_cast(float, __builtin_amdgcn_ds_bpermute((base12 + 4) << 2, __builtin_bit_cast(int, ss)));
            const float t2 = __builtin_bit_cast(float, __builtin_amdgcn_ds_bpermute((base12 + 8) << 2, __builtin_bit_cast(int, ss)));
            const float rs = rsqrtf((t0 + t1 + t2) * (1.f / 96.f) + EPS);
#pragma unroll
            for (int j = 0; j < 4; ++j) { const unsigned pw = (unsigned)__builtin_amdgcn_ds_bpermute(plane << 2, (int)v[u][j]); pf[2 * j] = bflo(pw); pf[2 * j + 1] = bfhi(pw); }
            const float scale = isk ? 1.f : QS96; const float fpos = (float)pos;
            u32x4 w;
            float y[8];
#pragma unroll
            for (int e = 0; e < 8; ++e) {
                const float xo = f[e] * rs * (isk ? gko[e] : gqo[e]);
                float r_ = xo;
                if (isrope) {
                    const float xp = pf[e] * rs * (isk ? gkp[e] : gqp[e]);
                    const float ang = fpos * freq[e];
                    const float n = rintf(ang * 0.15915494309189535f);
                    float r = fmaf(-n, 6.28318548202514648f, ang); r = fmaf(-n, -1.74845553146951715e-7f, r);
                    const float cs = __cosf(r), sn = __sinf(r);
                    r_ = isx1 ? (xo * cs - xp * sn) : (xo * cs + xp * sn);
                }
                y[e] = r_ * scale;
            }
#pragma unroll
            for (int j = 0; j < 4; ++j) w[j] = cvtpk(y[2 * j], y[2 * j + 1]);
            bf16_t* dst = !isk ? QM + (size_t)tok * 512 + h * 96 + 8 * c : KM + (size_t)tok * 384 + h * 96 + 8 * c;
            if (act) *(u32x4*)dst = w;
        }
    }
}


#define XB_TMO      128
#define XB_XCNT(j)  (256  + 64 * (j))
#define XB_XSUB(j)  (1280 + 64 * (j))
#define XB_XGEN(j)  (2304 + 64 * (j))
#define XB_TOP      3328
#define XB_TOPGEN   3392
#define XCD_BAR_WORDS 3456
#define XB_SPIN_CAP (1u << 18)

__device__ __forceinline__ unsigned xb_ld(unsigned* p)              { return __hip_atomic_load(p, __ATOMIC_RELAXED, __HIP_MEMORY_SCOPE_AGENT); }
__device__ __forceinline__ unsigned xb_add(unsigned* p, unsigned v) { return __hip_atomic_fetch_add(p, v, __ATOMIC_RELAXED, __HIP_MEMORY_SCOPE_AGENT); }
__device__ __forceinline__ unsigned xb_xcc_id() { return (unsigned)__builtin_amdgcn_s_getreg((3 << 11) | 20) & 0xFu; }
#define XB_SPIN(cond, bar) do { unsigned _sp = 0; while (cond) { __builtin_amdgcn_s_sleep(1); \
    if ((++_sp & 255u) == 0u) { if (xb_ld(&(bar)[XB_TMO])) break; if (_sp > XB_SPIN_CAP) { atomicAdd(&(bar)[XB_TMO], 1u); break; } } } } while (0)

struct XcdBarrier {
    unsigned* bar; unsigned x;
    volatile LAS unsigned* st;
};

__device__ __forceinline__ XcdBarrier xcd_barrier_post(unsigned* bar, volatile LAS unsigned* st) {
    XcdBarrier b; b.bar = bar; b.x = xb_xcc_id(); b.st = st;
    if (threadIdx.x == 0) (void)xb_add(&bar[XB_XCNT(b.x)], 1u);
    return b;
}
__device__ __forceinline__ void xcd_barrier_complete(unsigned* bar, unsigned x, unsigned& nloc, unsigned& nx) {
    const unsigned G = gridDim.x * gridDim.y * gridDim.z;
    unsigned sum, cnt, mine, sp = 0u;
    for (;;) {
        sum = 0u; cnt = 0u; mine = 0u;
#pragma unroll
        for (unsigned j = 0; j < 16; ++j) { const unsigned c = xb_ld(&bar[XB_XCNT(j)]); sum += c; cnt += (c > 0u) ? 1u : 0u; mine = (j == x) ? c : mine; }
        if (sum == G) break;
        __builtin_amdgcn_s_sleep(1);
        if ((++sp & 255u) == 0u) { if (xb_ld(&bar[XB_TMO])) break; if (sp > XB_SPIN_CAP) { atomicAdd(&bar[XB_TMO], 1u); break; } }
    }
    nloc = mine > 0u ? mine : 1u; nx = cnt > 0u ? cnt : 1u;
}

__device__ __forceinline__ void xcd_barrier(const XcdBarrier& b) {
    asm volatile("s_waitcnt vmcnt(0)" ::: "memory");
    __syncthreads();
    if (threadIdx.x == 0) {
        unsigned* bar = b.bar;
        __builtin_amdgcn_s_waitcnt(0);
        unsigned nloc = b.st[0], nx = b.st[1];
        if (nloc == 0u) { xcd_barrier_complete(bar, b.x, nloc, nx); b.st[0] = nloc; b.st[1] = nx; }
        const unsigned old = xb_add(&bar[XB_XSUB(b.x)], 1u);
        const unsigned gen = old / nloc;
        if (old + 1u == (gen + 1u) * nloc) {
            __builtin_amdgcn_fence(__ATOMIC_RELEASE, "agent");
            asm volatile("s_waitcnt vmcnt(0)" ::: "memory");
            const unsigned og = xb_add(&bar[XB_TOP], 1u);
            const unsigned tg = og / nx;
            if (og + 1u == (tg + 1u) * nx) xb_add(&bar[XB_TOPGEN], 1u);
            else XB_SPIN(xb_ld(&bar[XB_TOPGEN]) == tg, bar);
            __builtin_amdgcn_fence(__ATOMIC_ACQUIRE, "agent");
            xb_add(&bar[XB_XGEN(b.x)], 1u);
            asm volatile("s_waitcnt vmcnt(0)" ::: "memory");
        } else {
            XB_SPIN(xb_ld(&bar[XB_XGEN(b.x)]) == gen, bar);
            __builtin_amdgcn_fence(__ATOMIC_ACQUIRE, "agent");
            asm volatile("s_waitcnt vmcnt(0)" ::: "memory");
        }
    }
    __syncthreads();
}


constexpr int PH_PER_LAYER = 11, PH_PRE = 3, N_PHASES = PH_PRE + DEPTH * PH_PER_LAYER;

struct Job { pg8::Gemm g; int kind; bf16_t* O; int ldc; const float* SS; float invn; const float* base; float* out; float* SSo; };

__global__ void __launch_bounds__(512, 2) mk_fwd(Args a) {
    extern __shared__ __attribute__((aligned(16))) unsigned char lds_raw[];
    LAS unsigned char* lds = (LAS unsigned char*)lds_raw;
    cg::grid_group grid = cg::this_grid();
    const int bx = blockIdx.x;
    bool dup = false;
    volatile LAS unsigned* bst = (volatile LAS unsigned*)(lds + 131072 + 64);
    if (threadIdx.x < 2) bst[threadIdx.x] = 0u;
    __syncthreads();
    const XcdBarrier xbar = xcd_barrier_post((unsigned*)(a.ws + WS_BAR), bst);
    int nsync = 0;
#define GRID_BAR() do { if (nsync == 0) grid.sync(); else xcd_barrier(xbar); ++nsync; } while (0)
    for (int ph = a.ph_lo; ph < a.ph_hi; ++ph) {
    unsigned char* ws = a.ws; asm volatile("" : "+s"(ws));
    bf16_t* XB = (bf16_t*)(ws + WS_XB); bf16_t* PROJ = (bf16_t*)(ws + WS_PROJ); bf16_t* VT = (bf16_t*)(ws + WS_VT); bf16_t* QM = (bf16_t*)(ws + WS_QM);
    bf16_t* KN = (bf16_t*)(ws + WS_KN); bf16_t* KM = (bf16_t*)(ws + WS_KM); bf16_t* VTM = (bf16_t*)(ws + WS_VTM); bf16_t* HB = (bf16_t*)(ws + WS_H);
    bf16_t* Y = (bf16_t*)(ws + WS_Y); bf16_t* QMEM = (bf16_t*)(ws + WS_QMEM); bf16_t* OMEM = (bf16_t*)(ws + WS_OMEM); bf16_t* MEMB = (bf16_t*)(ws + WS_MEMB);
    bf16_t* XLO = (bf16_t*)a.out;
    bf16_t* XLO2 = (bf16_t*)(ws + WS_PROJ);
    float* SS = (float*)(ws + WS_SS); float* SM = (float*)(ws + WS_RSTDM); float* RS = (float*)(ws + WS_RSTD); float* CQS = (float*)(ws + WS_CQS);

        int tid_ = threadIdx.x; asm volatile("" : "+v"(tid_));
        int G_ = gridDim.x; asm volatile("" : "+s"(G_)); const int G = G_, NGW = G * 8;
        const int tid = tid_, lane = tid & 63, wave = __builtin_amdgcn_readfirstlane(tid >> 6), gw = bx * 8 + wave;
        int l = 0, sub = -1;
        if (ph >= PH_PRE) { l = (ph - PH_PRE) / PH_PER_LAYER; sub = (ph - PH_PRE) % PH_PER_LAYER; }
        if (sub == 1 || sub == 3) continue;
        unsigned char* wl = ws + WS_W + (size_t)l * WL_STRIDE;
        bf16_t* KMEMl = (bf16_t*)(ws + WS_KMEM) + (size_t)l * MROWS * 256; bf16_t* VTMEMl = (bf16_t*)(ws + WS_VTMEM) + (size_t)l * 256 * MROWS;
        int njobs = 0;
        if (ph == 1) njobs = 2 * DEPTH;
        else if (sub == 0) njobs = 2; else if (sub == 2) njobs = 3; else if (sub == 5 || sub == 6 || sub == 8 || sub == 9 || sub == 10) njobs = 1;
        if (ph == 0) prologue_phase(a, lds, gw, NGW, wave, lane);
        else if (ph == 2) memk_phase(a, gw, NGW, lane);
        else if (sub == 1) post1_phase(a, l, gw, NGW, lane);
        else if (sub == 3) post2_phase(a, l, gw, NGW, lane);
        else if (sub == 4) {
            const float* lp = a.in[7] + l * 256;
            const float d1 = wave_sum(lp[lane] * lp[64 + lane], lane), d2 = wave_sum(lp[128 + lane] * lp[192 + lane], lane);
            const float lam_init = 0.8f - 0.6f * expf(-0.3f * (float)l), lam = expf(d1) - expf(d2) + lam_init;
            const bool xl = (G == 256);
            for (int jj = 0; ; ++jj) {
                int cls, bh;
                if (xl) { if (jj >= 16) break; const int w = ((bx >> 3) + 4 * (jj >> 1)) & 31; cls = (jj & 1) ? 31 - w : w; bh = (bx & 7) + 8 * jj; }
                else { const int k = jj * G + ((jj & 1) ? G - 1 - bx : bx); if (k >= 4096) break; cls = k >> 7; bh = k & 127; }
                const int b = bh >> 2, h = bh & 3;
                int code;
                { const unsigned char tab[32] = {15, 14, 16 + 7, 13, 12, 16 + 6, 11, 10, 16 + 5, 9, 8, 16 + 4, 7, 16 + 3, 6, 32 + 7, 32 + 6, 32 + 5, 32 + 4, 32 + 3, 32 + 2, 32 + 1,
                                                 5, 16 + 2, 4, 3, 32 + 0, 16 + 1, 2, 1, 16 + 0, 0}; code = tab[cls]; }
                const int typ = code >> 4, lvl = code & 15, grp = typ == 1 ? 0 : (typ == 2 ? 3 : 1);
                if (PROBE_ATT_ONLY >= 0 && dup && typ != PROBE_ATT_ONLY) continue;
                const size_t rb = (size_t)b * SEQ;
                if (grp == 0) at::attn_unit<1>(lds, QM + rb * 512 + h * 96, 512, KM + rb * 384 + h * 96, 384, VTM + (size_t)(h * 64) * MT + rb, MT, Y + rb * DM + 768 + h * 64, DM,
                                               256 * lvl, 4 * lvl + 4, a.in[16] + l * 64, nullptr, 0.f, 1.f, a.in[14] + l * 96);
                else if (grp == 3) { const int hp = h >> 1, i = 2 * lvl + (h & 1);
                    at::attn_unit<2>(lds, PROJ + rb * LDP + 1024 + hp * 128, LDP, PROJ + rb * LDP + 1280 + hp * 128, LDP, VT + (size_t)(512 + hp * 128) * MT + rb, MT, Y + rb * DM + 512 + hp * 128, DM,
                                     128 * i, 2 * i + 2, a.in[9] + l * 64, nullptr, 0.f, 1.f, nullptr); }
                else { const int i = lvl;
                    at::attn_unit<0>(lds, PROJ + rb * LDP + h * 128, LDP, PROJ + rb * LDP + 512 + h * 128, LDP, VT + (size_t)(h * 128) * MT + rb, MT, Y + rb * DM + h * 128, DM,
                                     128 * i, 2 * i + 2, a.in[8] + l * 128, a.in[2] + h * 2, lam, 1.f - lam_init, nullptr); }
            }
        } else if (sub == 7) {
            for (int u = bx; u < 1024; u += G) { const int qb = u & 7, bh = u >> 3, b = bh >> 2, h = bh & 3; const size_t rb = (size_t)b * SEQ;
                at::attn_unit<3>(lds, QMEM + rb * 256 + h * 64, 256, KMEMl + (size_t)b * NMEM * 256 + h * 64, 256, VTMEMl + (size_t)(h * 64) * MROWS + b * NMEM, MROWS, OMEM + rb * 256 + h * 64, 256,
                                 256 * qb, 4, nullptr, nullptr, 0.f, 1.f, a.in[22] + l * 64); }
        }
        for (int j = 0; j < njobs; ++j) {
            int Gj = G, cj = bx;
            if (ph == 1 && G == 256) { if (j != (bx >> 5)) continue; Gj = 32; cj = bx & 31; }
            Job J; J.SS = nullptr; J.invn = 0.f; J.SSo = SS; J.base = nullptr; J.out = nullptr; J.O = nullptr; J.ldc = 0; J.kind = 0;
            if (ph == 1) { const int ll = j >> 1; unsigned char* w2 = ws + WS_W + (size_t)ll * WL_STRIDE; const bf16_t* wkv = (const bf16_t*)(w2 + WL_MKV);
                if ((j & 1) == 0) { J.g = pg8::Gemm{MEMB, wkv, MROWS, 256, 1024, 1024, 1024}; J.kind = 0; J.O = (bf16_t*)(ws + WS_KMEM) + (size_t)ll * MROWS * 256; J.ldc = 256; J.SS = SM; }
                else { J.g = pg8::Gemm{wkv + 256 * 1024, MEMB, 256, MROWS, 1024, 1024, 1024}; J.kind = 2; J.O = (bf16_t*)(ws + WS_VTMEM) + (size_t)ll * 256 * MROWS; J.ldc = MROWS; J.SS = SM; }
            } else if (sub == 0) { const bf16_t* win = (const bf16_t*)(wl + WL_IN);
                if (j == 0) { J.g = pg8::Gemm{XB, win, MT, 2048, 1024, 1024, 1024}; J.kind = 4; J.O = PROJ; J.ldc = LDP; J.SS = RS; J.base = a.in[5] + l * 64; J.out = const_cast<float*>(a.in[6] + l * 64); J.SSo = CQS; }
                else { J.g = pg8::Gemm{win + 2048 * 1024, XB, 768, MT, 1024, 1024, 1024}; J.kind = 2; J.O = VT; J.ldc = MT; J.SS = RS; }
            } else if (sub == 2) {
                if (j == 0) { J.g = pg8::Gemm{PROJ + 1536, (const bf16_t*)(wl + WL_UQ), MT, 512, 256, LDP, 256}; J.kind = 0; J.O = QM; J.ldc = 512; J.SS = CQS; J.invn = 1.f / 256.f; }
                else if (j == 1) { J.g = pg8::Gemm{PROJ + 1792, (const bf16_t*)(wl + WL_UK), MT, 256, 128, LDP, 128}; J.kind = 5; J.O = KM; J.ldc = 384; J.SS = CQS + (size_t)MT * 4; J.base = a.in[15] + l * 96; J.out = (float*)PROJ; J.SSo = CQS + (size_t)2 * MT * 4; }
                else { J.g = pg8::Gemm{(const bf16_t*)(wl + WL_UV), PROJ + 1792, 256, MT, 128, 128, LDP}; J.kind = 2; J.O = VTM; J.ldc = MT; J.SS = CQS + (size_t)MT * 4; J.invn = 1.f / 128.f; }
            } else if (sub == 5) { J.g = pg8::Gemm{Y, (const bf16_t*)(wl + WL_OUT), MT, 1024, 1024, 1024, 1024}; J.kind = 3; J.SS = (const float*)XLO; J.O = (l == DEPTH - 1) ? XLO2 : XLO; }
            else if (sub == 6) { J.g = pg8::Gemm{XB, (const bf16_t*)(wl + WL_MQ), MT, 256, 1024, 1024, 1024}; J.kind = 0; J.O = QMEM; J.ldc = 256; J.SS = RS; }
            else if (sub == 8) { J.g = pg8::Gemm{OMEM, (const bf16_t*)(wl + WL_MO), MT, 1024, 256, 256, 256}; J.kind = 3;
                if (l == DEPTH - 1) { J.SS = (const float*)XLO2; J.out = a.out; } else { J.SS = (const float*)XLO; J.O = XLO; } }
            else if (sub == 9) { J.g = pg8::Gemm{XB, (const bf16_t*)(wl + WL_F1), MT, 4096, 1024, 1024, 1024}; J.kind = 1; J.O = HB; J.ldc = 4096; J.SS = RS; }
            else { J.g = pg8::Gemm{HB, (const bf16_t*)(wl + WL_F2), MT, 1024, 4096, 4096, 4096}; J.kind = 3;
                if (l == DEPTH - 1) { J.base = a.out; J.out = a.out; } else { J.SS = (const float*)XLO; J.O = XLO; } }
            pg8::StaticOrder S; S.init(J.g.M, J.g.N, Gj, cj, 0);
            if (J.SS == RS && !(l == 0 && sub == 0)) {
                pg8::Unit fu;
                for (int i = 0; S.next(i, fu); ++i) if (tid < 256) { const int row = (J.kind == 2 ? fu.pn : fu.pm) * 256 + tid;
                    const f32x4* p = (const f32x4*)(SS + (size_t)row * 16); const f32x4 q0 = p[0], q1 = p[1], q2 = p[2], q3 = p[3];
                    const float sm = (((q0.x + q0.y) + (q0.z + q0.w)) + ((q1.x + q1.y) + (q1.z + q1.w))) + (((q2.x + q2.y) + (q2.z + q2.w)) + ((q3.x + q3.y) + (q3.z + q3.w)));
                    RS[row] = rsqrtf(sm * (1.f / 1024.f) + EPS); }
                __syncthreads();
            }
            { pg8::EpiAny E{J.kind, J.O, J.ldc, J.SS, J.invn, J.base, J.out, XB, J.SSo}; pg8::gemm_phase(lds, J.g, S, E); }
            __syncthreads();
        }
        if (PROBE_COND && !dup) { dup = true; GRID_BAR(); ph -= PROBE_BACK; continue; }
        if (PROBE_COND) dup = false;
        if (ph + 1 < a.ph_hi) GRID_BAR();
    }
}

extern "C" void kernel_launch(void* const* d_in, const int* in_sizes, int n_in, void* d_out, int out_size, void* d_ws, size_t ws_size, hipStream_t stream) {
    static int grid = 0;
    if (grid == 0) {
        if (n_in != 28 || in_sizes[0] != MT * DM || out_size != MT * DM || ws_size < WS_END) {
            fprintf(stderr, "kernel_launch: unexpected shapes (n_in %d, in0 %d, out %d, ws %zu); nothing launched\n", n_in, n_in > 0 ? in_sizes[0] : -1, out_size, ws_size); grid = -1; return; }
        int dev = 0, cus = 0, per_cu = 0;
        hipGetDevice(&dev); hipDeviceGetAttribute(&cus, hipDeviceAttributeMultiprocessorCount, dev);
        if (hipFuncSetAttribute((const void*)mk_fwd, hipFuncAttributeMaxDynamicSharedMemorySize, LDS_BYTES) != hipSuccess) { fprintf(stderr, "kernel_launch: hipFuncSetAttribute failed\n"); grid = -1; return; }
        if (hipOccupancyMaxActiveBlocksPerMultiprocessor(&per_cu, (const void*)mk_fwd, 512, LDS_BYTES) != hipSuccess || per_cu < 1) { fprintf(stderr, "kernel_launch: occupancy query says %d\n", per_cu); per_cu = 1; }
        (void)hipGetLastError();
        grid = cus * (per_cu > 1 ? 1 : per_cu);
    }
    if (grid < 0) return;
    Args a{};
    for (int i = 0; i < 28; ++i) a.in[i] = (const float*)d_in[i];
    a.out = (float*)d_out; a.ws = (unsigned char*)d_ws;
    (void)hipMemsetAsync((unsigned char*)d_ws + WS_BAR, 0, 16384, stream);
    a.ph_lo = 0; a.ph_hi = N_PHASES;
    void* args[] = {&a};
    hipError_t e = hipLaunchCooperativeKernel((const void*)mk_fwd, dim3(grid), dim3(512), args, LDS_BYTES, stream);
    if (e != hipSuccess) fprintf(stderr, "kernel_launch: cooperative launch failed: %s (grid %d)\n", hipGetErrorString(e), grid);
}
```

```cpp
#include <hip/hip_runtime.h>
#include <hip/hip_cooperative_groups.h>
#include <cstdio>
#include <cstdint>
namespace cg = cooperative_groups;

#ifndef MK_MULTI
#define MK_MULTI 0
#endif
#ifndef PROBE_DUP
#define PROBE_ATT_ONLY -1
#define PROBE_COND false
#define PROBE_BACK 1
#define PROBE_DUP -1
#endif
#ifndef SB_EARLY
#define SB_EARLY 1
#endif

#define LAS __attribute__((address_space(3)))
#define DI __device__ __forceinline__
typedef unsigned short bf16_t;
typedef short bf16x8 __attribute__((ext_vector_type(8)));
typedef short s16x4 __attribute__((ext_vector_type(4)));
typedef float f32x4 __attribute__((ext_vector_type(4)));
typedef float f32x16 __attribute__((ext_vector_type(16)));
typedef unsigned u32x4 __attribute__((ext_vector_type(4)));
typedef unsigned u32x2 __attribute__((ext_vector_type(2)));
typedef float f32x2_t __attribute__((ext_vector_type(2)));
typedef __bf16 bf16x2_t __attribute__((ext_vector_type(2)));

constexpr int BATCH = 32, SEQ = 2048, DM = 1024, DEPTH = 4, NMEM = 256, DFF = 4096;
constexpr int MT = BATCH * SEQ;
constexpr int MROWS = BATCH * NMEM;
constexpr int LDP = 2048;
constexpr float EPS = 1e-6f;
constexpr float LOG2E = 1.4426950408889634f;
constexpr float QS64 = 0.125f * LOG2E;
constexpr float QS96 = 0.10206207261596577f * LOG2E;

constexpr size_t MiB = 1u << 20;
constexpr size_t WS_XB = 0;
constexpr size_t WS_R = 128 * MiB;
constexpr size_t WS_PROJ = WS_R;
constexpr size_t WS_VT = WS_R + 256 * MiB;
constexpr size_t WS_QM = WS_R + 352 * MiB;
constexpr size_t WS_KN = WS_R + 416 * MiB;
constexpr size_t WS_KM = WS_R + 448 * MiB;
constexpr size_t WS_VTM = WS_R + 496 * MiB;
constexpr size_t WS_H = WS_R;
constexpr size_t WS_Y = 656 * MiB;
constexpr size_t WS_QMEM = WS_Y;
constexpr size_t WS_OMEM = WS_Y + 32 * MiB;
constexpr size_t WS_W = 784 * MiB;
constexpr size_t WL_STRIDE = 26 * MiB;
constexpr size_t WL_IN = 0, WL_UQ = 5767168, WL_UK = 6029312, WL_UV = 6094848, WL_OUT = 6160384, WL_MQ = 8257536,
                 WL_MKV = 8781824, WL_MO = 9830400, WL_F1 = 10354688, WL_F2 = 18743296;
constexpr size_t WS_MEMB = 888 * MiB;
constexpr size_t WS_KMEM = 904 * MiB;
constexpr size_t WS_VTMEM = 920 * MiB;
constexpr size_t WS_SS = 936 * MiB;
constexpr size_t WS_RSTDM = 940 * MiB;
constexpr size_t WS_RSTD = 941 * MiB;
constexpr size_t WS_BAR = 942 * MiB;
constexpr size_t WS_CQS = 943 * MiB;
constexpr size_t WS_END = 945 * MiB;

constexpr int LDS_BYTES = 135168;

struct Args { const float* in[28]; float* out; unsigned char* ws; int ph_lo, ph_hi; };

DI unsigned cvtpk(float lo, float hi) { f32x2_t v = {lo, hi}; bf16x2_t b = __builtin_convertvector(v, bf16x2_t); return __builtin_bit_cast(unsigned, b); }
DI float shx(float v, int mask, int lane) { return __builtin_bit_cast(float, __builtin_amdgcn_ds_bpermute((lane ^ mask) << 2, __builtin_bit_cast(int, v))); }
DI float bflo(unsigned w) { return __uint_as_float(w << 16); }
DI float bfhi(unsigned w) { return __uint_as_float(w & 0xffff0000u); }
DI float rstd16(const float* SS, int row, float invn) {
    const f32x4* p = (const f32x4*)(SS + (size_t)row * 16); const f32x4 a = p[0], b = p[1], c = p[2], d = p[3];
    const float s = (((a.x + a.y) + (a.z + a.w)) + ((b.x + b.y) + (b.z + b.w))) + (((c.x + c.y) + (c.z + c.w)) + ((d.x + d.y) + (d.z + d.w)));
    return rsqrtf(s * invn + EPS);
}

namespace pg8 {
constexpr int BM = 256, BK = 64, HALF = 128, HTB = HALF * BK * 2, STAGE_BYTES = 8 * HTB, NXCD = 8, WGM = 8;
__host__ __device__ __forceinline__ int lds_byte(int r, int c) { const int st = (r >> 4) * 2 + (c >> 5), rr = r & 15, cc = c & 31, ob = rr * 64 + cc * 2; return st * 1024 + (ob ^ (((ob >> 9) & 1) << 5)); }
__host__ __device__ __forceinline__ void stage_rc(int b, int& R, int& C) { const int st = b / 1024, sb = b % 1024, swz = sb ^ (((sb >> 9) & 1) << 5); R = (st >> 1) * 16 + swz / 64; C = (st & 1) * 32 + (swz % 64) / 2; }
__host__ __device__ __forceinline__ int perm32(int rho) { const int n = rho >> 4, i = rho & 15; return 8 * (i >> 2) + 4 * n + (i & 3); }
struct Unit { int pm, pn; };
struct Gemm { const bf16_t* A; const bf16_t* Bt; int M, N, K, lda, ldb; };
struct StaticOrder {
    int nM, nN, nwg, G, c, rowmaj;
    __device__ void init(int M, int N, int G_, int c_, int rm) { nM = M / BM; nN = N / BM; nwg = nM * nN; G = G_; c = c_; rowmaj = rm; }
    __device__ bool next(int i, Unit& u) const {
        if (rowmaj) { const int pm = c + (i / nN) * G; if (pm >= nM) return false; u.pm = pm; u.pn = i % nN; return true; }
        const long L = (long)i * G + c; if (L >= nwg) return false;
        int wgid = (int)L; { const int q = nwg / NXCD, r = nwg % NXCD, xcd = wgid % NXCD, off = wgid / NXCD; wgid = (xcd < r ? xcd * (q + 1) : r * (q + 1) + (xcd - r) * q) + off; }
        const int nig = WGM * nN, gid = wgid / nig, fm = gid * WGM, gsz = (nM - fm) < WGM ? (nM - fm) : WGM;
        u.pm = fm + ((wgid % nig) % gsz); u.pn = (wgid % nig) / gsz; return true;
    }
};

template <int ACT  > struct EpiRow {
    static constexpr bool PERM = true;
    bf16_t* O; int ldc; const float* SS; float invn;
    DI void operator()(const f32x4 (&acc)[2][2][4][2], const Unit& u, int wr, int wc, int fr, int fq) const {
        const int row0 = u.pm * BM + wr * 64 + fr, col0 = u.pn * BM + wc * 32 + 8 * fq;
#pragma unroll
        for (int ai = 0; ai < 2; ++ai)
#pragma unroll
            for (int m = 0; m < 4; ++m) { const int row = row0 + ai * HALF + m * 16; float sc = 1.f; if (SS) { if (invn > 0.f) { const f32x4 q4 = *(const f32x4*)(SS + (size_t)row * 4); sc = rsqrtf(((q4.x + q4.y) + (q4.z + q4.w)) * invn + EPS); } else sc = SS[row]; }
                bf16_t* rowp = O + (size_t)row * ldc + col0;
#pragma unroll
                for (int bj = 0; bj < 2; ++bj) { f32x4 v0 = acc[ai][bj][m][0] * sc, v1 = acc[ai][bj][m][1] * sc;
                    if (ACT == 1) {
#pragma unroll
                        for (int e = 0; e < 4; ++e) { const float a = fmaxf(v0[e], 0.f), b = fmaxf(v1[e], 0.f); v0[e] = a * a; v1[e] = b * b; } }
                    u32x4 w; w.x = cvtpk(v0[0], v0[1]); w.y = cvtpk(v0[2], v0[3]); w.z = cvtpk(v1[0], v1[1]); w.w = cvtpk(v1[2], v1[3]);
                    if (ACT == 1) __builtin_nontemporal_store(w, (u32x4*)(rowp + bj * HALF));
                    else *(u32x4*)(rowp + bj * HALF) = w; }
                asm volatile("" ::: "memory"); }
    }
};
struct EpiCol {
    static constexpr bool PERM = true;
    bf16_t* O; int ldc; const float* SS; float invn;
    DI void operator()(const f32x4 (&acc)[2][2][4][2], const Unit& u, int wr, int wc, int fr, int fq) const {
        const int row0 = u.pm * BM + wr * 64 + fr, col0 = u.pn * BM + wc * 32 + 8 * fq;
#pragma unroll
        for (int bj = 0; bj < 2; ++bj) {
            float cs[8];
            if (invn > 0.f) {
#pragma unroll
                for (int j = 0; j < 8; ++j) { const f32x4 q4 = *(const f32x4*)(SS + (size_t)(col0 + bj * HALF + j) * 4); cs[j] = rsqrtf(((q4.x + q4.y) + (q4.z + q4.w)) * invn + EPS); }
            } else { const f32x4 c0 = *(const f32x4*)(SS + col0 + bj * HALF), c1 = *(const f32x4*)(SS + col0 + bj * HALF + 4);
              cs[0] = c0[0]; cs[1] = c0[1]; cs[2] = c0[2]; cs[3] = c0[3]; cs[4] = c1[0]; cs[5] = c1[1]; cs[6] = c1[2]; cs[7] = c1[3]; }
#pragma unroll
            for (int ai = 0; ai < 2; ++ai)
#pragma unroll
                for (int m = 0; m < 4; ++m) { const int row = row0 + ai * HALF + m * 16; bf16_t* rowp = O + (size_t)row * ldc + col0;
                    const f32x4 v0 = acc[ai][bj][m][0], v1 = acc[ai][bj][m][1];
                    u32x4 w; w.x = cvtpk(v0[0] * cs[0], v0[1] * cs[1]); w.y = cvtpk(v0[2] * cs[2], v0[3] * cs[3]);
                    w.z = cvtpk(v1[0] * cs[4], v1[1] * cs[5]); w.w = cvtpk(v1[2] * cs[6], v1[3] * cs[7]);
                    __builtin_nontemporal_store(w, (u32x4*)(rowp + bj * HALF)); }
            asm volatile("" ::: "memory");
        }
    }
};
struct EpiResid {
    static constexpr bool PERM = true;
    const float* fin; float* fout; bf16_t* xb; const bf16_t* loin; bf16_t* loout; float* SSo;
    DI void operator()(const f32x4 (&acc)[2][2][4][2], const Unit& u, int wr, int wc, int fr, int fq) const {
        const int col0 = u.pn * BM + wc * 32 + 8 * fq;
#pragma unroll
        for (int ai = 0; ai < 2; ++ai) {
            u32x4 pa[4][2], pb[4][2];
#pragma unroll
            for (int m = 0; m < 4; ++m) { const size_t off = (size_t)(u.pm * BM + ai * HALF + wr * 64 + m * 16 + fr) * DM + col0;
#pragma unroll
                for (int bj = 0; bj < 2; ++bj) {
                    if (fin) { pa[m][bj] = __builtin_nontemporal_load((const u32x4*)(fin + off + bj * HALF)); pb[m][bj] = __builtin_nontemporal_load((const u32x4*)(fin + off + bj * HALF + 4)); }
                    else { pa[m][bj] = *(const u32x4*)(xb + off + bj * HALF); pb[m][bj] = __builtin_nontemporal_load((const u32x4*)(loin + off + bj * HALF)); } } }
#pragma unroll
            for (int m = 0; m < 4; ++m) { const int row = u.pm * BM + ai * HALF + wr * 64 + m * 16 + fr; const size_t off = (size_t)row * DM + col0; float ss = 0.f;
#pragma unroll
                for (int bj = 0; bj < 2; ++bj) { const size_t o2 = off + bj * HALF;
                    float b[8];
                    if (fin) {
#pragma unroll
                        for (int j = 0; j < 4; ++j) { b[j] = __uint_as_float(pa[m][bj][j]); b[4 + j] = __uint_as_float(pb[m][bj][j]); }
                    } else {
#pragma unroll
                        for (int j = 0; j < 4; ++j) { b[2 * j] = bflo(pa[m][bj][j]) + bflo(pb[m][bj][j]); b[2 * j + 1] = bfhi(pa[m][bj][j]) + bfhi(pb[m][bj][j]); }
                    }
                    float o[8];
#pragma unroll
                    for (int j = 0; j < 4; ++j) { o[j] = b[j] + acc[ai][bj][m][0][j]; o[4 + j] = b[4 + j] + acc[ai][bj][m][1][j]; }
                    u32x4 w;
#pragma unroll
                    for (int j = 0; j < 4; ++j) w[j] = cvtpk(o[2 * j], o[2 * j + 1]);
                    if (!fin || loout || !fout) *(u32x4*)(xb + o2) = w;
                    if (loout) { u32x4 wl;
#pragma unroll
                        for (int j = 0; j < 4; ++j) wl[j] = cvtpk(o[2 * j] - bflo(w[j]), o[2 * j + 1] - bfhi(w[j]));
                        __builtin_nontemporal_store(wl, (u32x4*)(loout + o2)); }
                    if (fout) { __builtin_nontemporal_store((f32x4){o[0], o[1], o[2], o[3]}, (f32x4*)(fout + o2)); __builtin_nontemporal_store((f32x4){o[4], o[5], o[6], o[7]}, (f32x4*)(fout + o2 + 4)); }
#pragma unroll
                    for (int j = 0; j < 8; ++j) ss += o[j] * o[j]; }
                { const int ln = fr + 16 * fq; ss += shx(ss, 16, ln); ss += shx(ss, 32, ln); }
                if (fq == 0) SSo[(size_t)row * 16 + u.pn * 4 + wc] = ss; }
            asm volatile("" ::: "memory");
        }
    }
};
struct EpiGN {
    bf16_t* O; int ldc; const float* SS; const float* gq; const float* gk; float* CQ;
    DI void operator()(const f32x4 (&acc)[2][2][4][2], const Unit& u, int wr, int wc, int fr, int fq) const {
        if (u.pn >= 4) {
            const int row0 = u.pm * BM + wr * 64 + fr, col0 = u.pn * BM + wc * 32 + 8 * fq, ln = fr + 16 * fq;
#pragma unroll
            for (int ai = 0; ai < 2; ++ai)
#pragma unroll
                for (int m = 0; m < 4; ++m) { const int row = row0 + ai * HALF + m * 16; const float sc = SS[row]; bf16_t* rowp = O + (size_t)row * ldc + col0; float ss = 0.f;
                    float ss2 = 0.f;
#pragma unroll
                    for (int bj = 0; bj < 2; ++bj) { const f32x4 v0 = acc[ai][bj][m][0] * sc, v1 = acc[ai][bj][m][1] * sc;
                        if (bj == 1) ss2 = ((v0[0] * v0[0] + v0[1] * v0[1]) + (v0[2] * v0[2] + v0[3] * v0[3])) + ((v1[0] * v1[0] + v1[1] * v1[1]) + (v1[2] * v1[2] + v1[3] * v1[3]));
                        if (bj == 0 || u.pn == 6) ss += ((v0[0] * v0[0] + v0[1] * v0[1]) + (v0[2] * v0[2] + v0[3] * v0[3])) + ((v1[0] * v1[0] + v1[1] * v1[1]) + (v1[2] * v1[2] + v1[3] * v1[3]));
                        u32x4 w; w.x = cvtpk(v0[0], v0[1]); w.y = cvtpk(v0[2], v0[3]); w.z = cvtpk(v1[0], v1[1]); w.w = cvtpk(v1[2], v1[3]);
                        __builtin_nontemporal_store(w, (u32x4*)(rowp + bj * HALF)); }
                    if (u.pn >= 6) { ss += shx(ss, 16, ln); ss += shx(ss, 32, ln); if (fq == 0) CQ[(size_t)(u.pn - 6) * MT * 4 + (size_t)row * 4 + wc] = ss; }
                    if (u.pn == 7 && wc == 0) { ss2 += shx(ss2, 16, ln); ss2 += shx(ss2, 32, ln); if (fq == 0) CQ[(size_t)2 * MT * 4 + row] = ss2; }
                    asm volatile("" ::: "memory"); }
            return;
        }
        const float* gg = (u.pn < 2) ? gq : gk; const float ex = (u.pn < 2) ? QS64 : 1.f;
        const int row0 = u.pm * BM + wr * 64 + fr, ln = fr + 16 * fq;
        f32x4 g[2][2];
#pragma unroll
        for (int bj = 0; bj < 2; ++bj) { g[bj][0] = *(const f32x4*)(gg + 32 * bj + 8 * fq); g[bj][1] = *(const f32x4*)(gg + 32 * bj + 8 * fq + 4); }
#pragma unroll
        for (int ai = 0; ai < 2; ++ai)
#pragma unroll
            for (int m = 0; m < 4; ++m) { const int row = row0 + ai * HALF + m * 16; const float sc = SS[row];
                f32x4 v[2][2]; float ss = 0.f;
#pragma unroll
                for (int bj = 0; bj < 2; ++bj)
#pragma unroll
                    for (int n = 0; n < 2; ++n) { v[bj][n] = acc[ai][bj][m][n] * sc; ss += (v[bj][n][0] * v[bj][n][0] + v[bj][n][1] * v[bj][n][1]) + (v[bj][n][2] * v[bj][n][2] + v[bj][n][3] * v[bj][n][3]); }
                ss += shx(ss, 16, ln); ss += shx(ss, 32, ln);
                const float rs = rsqrtf(ss * (1.f / 64.f) + EPS) * ex;
                bf16_t* rowp = O + (size_t)row * ldc + u.pn * BM + wc * 64 + 8 * fq;
#pragma unroll
                for (int bj = 0; bj < 2; ++bj) { const f32x4 a0 = v[bj][0] * rs * g[bj][0], a1 = v[bj][1] * rs * g[bj][1];
                    u32x4 w; w.x = cvtpk(a0[0], a0[1]); w.y = cvtpk(a0[2], a0[3]); w.z = cvtpk(a1[0], a1[1]); w.w = cvtpk(a1[2], a1[3]);
                    __builtin_nontemporal_store(w, (u32x4*)(rowp + bj * 32)); }
                asm volatile("" ::: "memory"); }
    }
};
struct EpiKM {
    bf16_t* O; const float* SS; const float* gk; const bf16_t* proj; const float* krs;
    DI void operator()(const f32x4 (&acc)[2][2][4][2], const Unit& u, int wr, int wc, int fr, int fq) const {
        const int row0 = u.pm * BM + wr * 64 + fr, ln = fr + 16 * fq; const bool isx1 = fq < 2;
#pragma unroll
        for (int ai = 0; ai < 2; ++ai)
#pragma unroll
            for (int m = 0; m < 4; ++m) { const int row = row0 + ai * HALF + m * 16;
                const f32x4 q4 = *(const f32x4*)(SS + (size_t)row * 4); const float sc = rsqrtf(((q4.x + q4.y) + (q4.z + q4.w)) * (1.f / 128.f) + EPS);
                const u32x4 kr = *(const u32x4*)(proj + (size_t)row * LDP + 1920 + 8 * fq);
                int fqo = fq; asm volatile("" : "+v"(fqo));
                f32x4 v[2][2]; float ss = 0.f;
#pragma unroll
                for (int bj = 0; bj < 2; ++bj)
#pragma unroll
                    for (int n = 0; n < 2; ++n) { v[bj][n] = acc[ai][bj][m][n] * sc; ss += (v[bj][n][0] * v[bj][n][0] + v[bj][n][1] * v[bj][n][1]) + (v[bj][n][2] * v[bj][n][2] + v[bj][n][3] * v[bj][n][3]); }
                ss += shx(ss, 16, ln); ss += shx(ss, 32, ln);
                const float rs = rsqrtf((ss + krs[row]) * (1.f / 96.f) + EPS);
                bf16_t* rowp = O + (size_t)row * 384 + wc * 96 + 8 * fq;
                f32x4 go[2], gp[2]; float freq[8];
                go[0] = *(const f32x4*)(gk + 64 + 8 * fqo); go[1] = *(const f32x4*)(gk + 64 + 8 * fqo + 4); gp[0] = *(const f32x4*)(gk + 64 + 8 * (fqo ^ 2)); gp[1] = *(const f32x4*)(gk + 64 + 8 * (fqo ^ 2) + 4);
#pragma unroll
                for (int e = 0; e < 8; ++e) freq[e] = __builtin_amdgcn_exp2f(-(float)(8 * (fqo & 1) + e) * (13.287712379549449f / 16.f));
#pragma unroll
                for (int bj = 0; bj < 2; ++bj) { f32x4 g[2]; g[0] = *(const f32x4*)(gk + 32 * bj + 8 * fqo); g[1] = *(const f32x4*)(gk + 32 * bj + 8 * fqo + 4);
                    const f32x4 a0 = v[bj][0] * rs * g[0], a1 = v[bj][1] * rs * g[1];
                    u32x4 w; w.x = cvtpk(a0[0], a0[1]); w.y = cvtpk(a0[2], a0[3]); w.z = cvtpk(a1[0], a1[1]); w.w = cvtpk(a1[2], a1[3]);
                    *(u32x4*)(rowp + bj * 32) = w; }
                const float fpos = (float)(row & (SEQ - 1)); float y[8];
#pragma unroll
                for (int j = 0; j < 4; ++j) { const unsigned pw = (unsigned)__builtin_amdgcn_ds_bpermute((ln ^ 32) << 2, (int)kr[j]);
#pragma unroll
                    for (int hh = 0; hh < 2; ++hh) { const int e = 2 * j + hh; const float xo = (hh ? bfhi(kr[j]) : bflo(kr[j])) * rs * go[e >> 2][e & 3], xp = (hh ? bfhi(pw) : bflo(pw)) * rs * gp[e >> 2][e & 3];
                        const float ang = fpos * freq[e], nn = rintf(ang * 0.15915494309189535f);
                        float r = fmaf(-nn, 6.28318548202514648f, ang); r = fmaf(-nn, -1.74845553146951715e-7f, r);
                        const float cs = __cosf(r), sn = __sinf(r);
                        y[e] = isx1 ? (xo * cs - xp * sn) : (xo * cs + xp * sn); } }
                u32x4 w2; w2.x = cvtpk(y[0], y[1]); w2.y = cvtpk(y[2], y[3]); w2.z = cvtpk(y[4], y[5]); w2.w = cvtpk(y[6], y[7]);
                *(u32x4*)(rowp + 64) = w2;
                asm volatile("" ::: "memory"); }
    }
};
struct EpiAny {
    int kind; bf16_t* O; int ldc; const float* SS; float invn; const float* base; float* out; bf16_t* xb; float* SSo;
    DI bool perm() const { return true; }
    DI void operator()(const f32x4 (&acc)[2][2][4][2], const Unit& u, int wr, int wc, int fr, int fq) const {
        if (kind == 0) { EpiRow<0> e{O, ldc, SS, invn}; e(acc, u, wr, wc, fr, fq); }
        else if (kind == 1) { EpiRow<1> e{O, ldc, SS, invn}; e(acc, u, wr, wc, fr, fq); }
        else if (kind == 2) { EpiCol e{O, ldc, SS, invn}; e(acc, u, wr, wc, fr, fq); }
        else if (kind == 4) { EpiGN e{O, ldc, SS, base, (const float*)out, SSo}; e(acc, u, wr, wc, fr, fq); }
        else if (kind == 5) { EpiKM e{O, SS, base, (const bf16_t*)out, SSo}; e(acc, u, wr, wc, fr, fq); }
        else { EpiResid e{base, out, xb, (const bf16_t*)SS, O, SSo}; e(acc, u, wr, wc, fr, fq); }
    }
};
template <class Epi>
DI void gemm_phase(LAS unsigned char* lds, const Gemm g, const StaticOrder& S, const Epi& E) {
    int tid_ = threadIdx.x; asm volatile("" : "+v"(tid_));
    const int tid = tid_, wid = __builtin_amdgcn_readfirstlane(tid >> 6), lane = tid & 63, wr = wid >> 2, wc = wid & 3, fr = lane & 15, fq = lane >> 4;
    const int K = g.K, nt = K / BK;
    unsigned voffA[2], voffB[2];
#pragma unroll
    for (int i = 0; i < 2; ++i) { int R, C; stage_rc(tid * 16 + i * 8192, R, C); const int Rb = E.perm() ? ((R & ~31) + perm32(R & 31)) : R;
        voffA[i] = (unsigned)(R * g.lda + C) * 2u; voffB[i] = (unsigned)(Rb * g.ldb + C) * 2u; }
    const size_t kstep = (size_t)(BK * 2);
    const size_t hstepA = (size_t)HALF * g.lda * 2, hstepB = (size_t)HALF * g.ldb * 2;
    const size_t tstepA = 2 * hstepA, tstepB = 2 * hstepB;
    const unsigned ldsw = (unsigned)wid * 1024u;
    const int aoff = lds_byte(wr * 64 + fr, fq * 8), boff = lds_byte(wc * 32 + fr, fq * 8);
#define PG8_SA(b, h) (((b) * 2 + (h)) * HTB)
#define PG8_SB(b, h) ((4 + (b) * 2 + (h)) * HTB)
#define PG8_STAGE(bufoff, gbase, voff) do { _Pragma("unroll") for (int _i = 0; _i < 2; ++_i) \
        __builtin_amdgcn_global_load_lds((const unsigned*)((const char*)(gbase) + (voff)[_i]), (LAS unsigned*)(lds + (bufoff) + ldsw + _i * 8192), 16, 0, 0); } while (0)
#define PG8_LDA(dst, b, h) do { _Pragma("unroll") for (int m = 0; m < 4; ++m) _Pragma("unroll") for (int k = 0; k < 2; ++k) dst[m][k] = *(const LAS bf16x8*)(lds + PG8_SA(b, h) + aoff + m * 2048 + k * 1024); } while (0)
#define PG8_LDB(dst, b, h) do { _Pragma("unroll") for (int n = 0; n < 2; ++n) _Pragma("unroll") for (int k = 0; k < 2; ++k) dst[n][k] = *(const LAS bf16x8*)(lds + PG8_SB(b, h) + boff + n * 2048 + k * 1024); } while (0)
#define PG8_MMA(ai, bj, At, Bt) do { __builtin_amdgcn_s_setprio(1); _Pragma("unroll") for (int m = 0; m < 4; ++m) _Pragma("unroll") for (int n = 0; n < 2; ++n) _Pragma("unroll") for (int k = 0; k < 2; ++k) \
        acc[ai][bj][m][n] = __builtin_amdgcn_mfma_f32_16x16x32_bf16(Bt[n][k], At[m][k], acc[ai][bj][m][n], 0, 0, 0); __builtin_amdgcn_s_setprio(0); } while (0)
#define PG8_WAIT_V(n) asm volatile("s_waitcnt vmcnt(" #n ")" ::: "memory")
#define PG8_WAIT_L(n) asm volatile("s_waitcnt lgkmcnt(" #n ")" ::: "memory")
#define PG8_BAR __builtin_amdgcn_s_barrier()
#define PG8_SCHED __builtin_amdgcn_sched_barrier(0)
    Unit cur, nxt; int ui = 0;
    if (!S.next(0, cur)) return;
    const char* cA = (const char*)g.A + (size_t)cur.pm * tstepA; const char* cB = (const char*)g.Bt + (size_t)cur.pn * tstepB;
    PG8_STAGE(PG8_SB(0, 0), cB, voffB); PG8_STAGE(PG8_SB(0, 1), cB + hstepB, voffB); PG8_STAGE(PG8_SA(0, 0), cA, voffA); PG8_STAGE(PG8_SA(0, 1), cA + hstepA, voffA);
    if (wr == 1) PG8_BAR;
    PG8_WAIT_V(2); PG8_BAR;
    PG8_STAGE(PG8_SB(1, 0), cB + kstep, voffB); PG8_STAGE(PG8_SA(1, 0), cA + kstep, voffA); PG8_STAGE(PG8_SB(1, 1), cB + hstepB + kstep, voffB);
    PG8_WAIT_V(6); PG8_BAR;
    f32x4 acc[2][2][4][2];
#pragma unroll
    for (int a = 0; a < 2; ++a)
#pragma unroll
        for (int b = 0; b < 2; ++b)
#pragma unroll
            for (int m = 0; m < 4; ++m)
#pragma unroll
                for (int n = 0; n < 2; ++n) acc[a][b][m][n] = (f32x4){0.f, 0.f, 0.f, 0.f};
    bf16x8 At[4][2], B0[2][2], B1[2][2];
    for (;;) {
        const bool has_next = S.next(ui + 1, nxt);
        const char* nA = has_next ? (const char*)g.A + (size_t)nxt.pm * tstepA : cA; const char* nB = has_next ? (const char*)g.Bt + (size_t)nxt.pn * tstepB : cB;
        for (int t = 0; t < nt; t += 2) {
            const bool last = (t == nt - 2);
            const char* a1 = cA + (size_t)(t + 1) * kstep;
            const char* a2 = last ? nA : cA + (size_t)(t + 2) * kstep; const char* b2 = last ? nB : cB + (size_t)(t + 2) * kstep;
            const char* a3 = a2 + kstep; const char* b3 = b2 + kstep;
            PG8_LDB(B0, 0, 0); PG8_LDB(B1, 0, 1); PG8_SCHED; PG8_LDA(At, 0, 0); PG8_STAGE(PG8_SA(1, 1), a1 + hstepA, voffA);
            PG8_WAIT_V(8); PG8_WAIT_L(0); PG8_BAR; PG8_MMA(0, 0, At, B0); PG8_MMA(0, 1, At, B1); PG8_BAR; PG8_SCHED;
            PG8_LDA(At, 0, 1); PG8_STAGE(PG8_SB(0, 0), b2, voffB); PG8_STAGE(PG8_SB(0, 1), b2 + hstepB, voffB); PG8_STAGE(PG8_SA(0, 0), a2, voffA);
            PG8_WAIT_V(8); PG8_WAIT_L(0); PG8_BAR; PG8_MMA(1, 0, At, B0); PG8_MMA(1, 1, At, B1); PG8_BAR; PG8_SCHED;
            PG8_LDB(B0, 1, 0); PG8_LDB(B1, 1, 1); PG8_SCHED; PG8_LDA(At, 1, 0); PG8_STAGE(PG8_SA(0, 1), a2 + hstepA, voffA);
            PG8_WAIT_V(8); PG8_WAIT_L(0); PG8_BAR; PG8_MMA(0, 0, At, B0); PG8_MMA(0, 1, At, B1); PG8_BAR; PG8_SCHED;
            PG8_LDA(At, 1, 1); PG8_STAGE(PG8_SB(1, 0), b3, voffB); PG8_STAGE(PG8_SB(1, 1), b3 + hstepB, voffB); PG8_STAGE(PG8_SA(1, 0), a3, voffA);
            PG8_WAIT_V(8); PG8_WAIT_L(0); PG8_BAR; PG8_MMA(1, 0, At, B0); PG8_MMA(1, 1, At, B1); PG8_BAR; PG8_SCHED;
        }
        if (wr == 0) PG8_BAR;
        E(acc, cur, wr, wc, fr, fq);
        if (!has_next) break;
#pragma unroll
        for (int a = 0; a < 2; ++a)
#pragma unroll
            for (int b = 0; b < 2; ++b)
#pragma unroll
                for (int m = 0; m < 4; ++m)
#pragma unroll
                    for (int n = 0; n < 2; ++n) acc[a][b][m][n] = (f32x4){0.f, 0.f, 0.f, 0.f};
        cur = nxt; cA = nA; cB = nB; ++ui;
        if (wr == 1) PG8_BAR;
    }
    PG8_WAIT_V(0);
    PG8_BAR;
#undef PG8_SA
#undef PG8_SB
#undef PG8_STAGE
#undef PG8_LDA
#undef PG8_LDB
#undef PG8_MMA
#undef PG8_WAIT_V
#undef PG8_WAIT_L
#undef PG8_BAR
#undef PG8_SCHED
}
}

namespace at {
constexpr int KB0 = 0, KB1 = 17408, VB0 = 34816, VBSZ = 17408, TBL = 87040, FLG = 89600, VSTR = 136;
#define MFMA32(a, b, c) __builtin_amdgcn_mfma_f32_32x32x16_bf16((a), (b), (c), 0, 0, 0)
DI float ex2(float x) { return __builtin_amdgcn_exp2f(x); }
DI float lg2(float x) { return __builtin_amdgcn_logf(x); }

template <int MODE> struct Cfg;
template <> struct Cfg<0> { static constexpr int DQK = 64, KW = 256, DV = 128, ROWS = 128; };
template <> struct Cfg<1> { static constexpr int DQK = 96, KW = 192, DV = 64, ROWS = 256; };
template <> struct Cfg<2> { static constexpr int DQK = 64, KW = 256, DV = 128, ROWS = 128; };
template <> struct Cfg<3> { static constexpr int DQK = 64, KW = 128, DV = 64, ROWS = 256; };

DI void sb_prep(f32x16& P, f32x16& L, int kb, int qrow, bool diag) {
#pragma unroll
    for (int i = 0; i < 16; ++i) {
        const float z = P[i], e = ex2(-fabsf(z)), sp = fmaxf(z, 0.f) + lg2(1.f + e);
        float l = -sp, lb = z - sp;
        if (diag) { const int key = kb + (i & 3) + 8 * (i >> 2); if (key >= qrow) { l = 0.f; lb = -1e30f; } }
        L[i] = l; P[i] = lb;
    }
}

template <int MODE>
DI void attn_unit(LAS unsigned char* lds, const bf16_t* Qg, int ldq, const bf16_t* Kg, int ldk, const bf16_t* VTg, int ldvt, bf16_t* Og, int ldo,
                  int q0, int NT, const float* gout, const float* relb, float lam, float osc, const float* qgain) {
    typedef Cfg<MODE> C;
    constexpr int NS = C::DQK / 16, KSTR = C::KW + 16, KCH = C::KW / 16, NKCH = 64 * KCH, KJ = (NKCH + 511) / 512, NVCH = C::DV * 8, VJ = NVCH / 512, NDB = (MODE == 2) ? 2 : C::DV / 32;
    int tid_ = threadIdx.x; asm volatile("" : "+v"(tid_));
    const int tid = tid_, lane = tid & 63, wid = __builtin_amdgcn_readfirstlane(tid >> 6), r32 = lane & 31, hi = lane >> 5;
    const int rg = (MODE == 0 || MODE == 2) ? (wid & 3) : wid, mm = (MODE == 0 || MODE == 2) ? (wid >> 2) : 0;
    const int qrow = q0 + 32 * rg + r32;
    int ntw = NT, TD = 0;
    if (MODE == 0 || MODE == 1) ntw = (q0 + 32 * rg) / 64 + 1;
    if (MODE == 2) TD = (q0 + 32 * rg + 31) / 64;

    bf16x8 qf[NS];
    {
        const bf16_t* qp = Qg + (size_t)qrow * ldq + mm * 64 + 8 * hi;
#pragma unroll
        for (int s = 0; s < NS; ++s) qf[s] = *(const bf16x8*)(qp + 16 * s);
        if (MODE == 1) {
            float ss = 0.f; float f[NS][8];
#pragma unroll
            for (int s = 0; s < NS; ++s) { const u32x4 w = __builtin_bit_cast(u32x4, qf[s]);
#pragma unroll
                for (int j = 0; j < 4; ++j) { f[s][2 * j] = bflo(w[j]); f[s][2 * j + 1] = bfhi(w[j]); ss += f[s][2 * j] * f[s][2 * j] + f[s][2 * j + 1] * f[s][2 * j + 1]; } }
            ss += shx(ss, 32, lane);
            const float rs = rsqrtf(ss * (1.f / 96.f) + EPS);
#pragma unroll
            for (int s = 0; s < NS; ++s) { const float* gp = qgain + 16 * s + 8 * hi;
#pragma unroll
                for (int j = 0; j < 8; ++j) f[s][j] *= rs * gp[j]; }
            const float fpos = (float)qrow;
#pragma unroll
            for (int j = 0; j < 8; ++j) {
                const float freq = __builtin_amdgcn_exp2f(-(float)(8 * hi + j) * (13.287712379549449f / 16.f));
                const float ang = fpos * freq, n = rintf(ang * 0.15915494309189535f);
                float r = fmaf(-n, 6.28318548202514648f, ang); r = fmaf(-n, -1.74845553146951715e-7f, r);
                const float cs = __cosf(r), sn = __sinf(r), x1 = f[4][j], x2 = f[5][j];
                f[4][j] = x1 * cs - x2 * sn; f[5][j] = x2 * cs + x1 * sn;
            }
#pragma unroll
            for (int s = 0; s < NS; ++s) { u32x4 w;
#pragma unroll
                for (int j = 0; j < 4; ++j) w[j] = cvtpk(f[s][2 * j] * QS96, f[s][2 * j + 1] * QS96);
                qf[s] = __builtin_bit_cast(bf16x8, w); }
        }
        if (MODE == 3) {
            float ss = 0.f; float f[NS][8];
#pragma unroll
            for (int s = 0; s < NS; ++s) { const u32x4 w = __builtin_bit_cast(u32x4, qf[s]);
#pragma unroll
                for (int j = 0; j < 4; ++j) { f[s][2 * j] = bflo(w[j]); f[s][2 * j + 1] = bfhi(w[j]); ss += f[s][2 * j] * f[s][2 * j] + f[s][2 * j + 1] * f[s][2 * j + 1]; } }
            ss += shx(ss, 32, lane);
            const float rs = rsqrtf(ss * (1.f / 64.f) + EPS) * QS64;
#pragma unroll
            for (int s = 0; s < NS; ++s) { const float* gp = qgain + 16 * s + 8 * hi; u32x4 w;
#pragma unroll
                for (int j = 0; j < 4; ++j) w[j] = cvtpk(f[s][2 * j] * rs * gp[2 * j], f[s][2 * j + 1] * rs * gp[2 * j + 1]);
                qf[s] = __builtin_bit_cast(bf16x8, w); }
        }
    }
    float c15 = 0.f;
    if (MODE == 0) {
        LAS float* tb = (LAS float*)(lds + TBL);
        for (int idx = tid; idx < 640; idx += 512) { const int m2 = idx / 320, rel = (idx % 320) - 256; const int n = rel < 0 ? -rel : rel;
            int bk = rel > 0 ? 16 : 0; if (n < 8) bk += n; else { int lg = (31 - __clz(n * n)) + 2; bk += lg > 15 ? 15 : lg; }
            tb[idx] = (relb[bk * 8 + m2] - relb[15 * 8 + m2]) * LOG2E; }
        c15 = relb[15 * 8 + mm] * LOG2E;
    }
    u32x4 kr[KJ], vr[VJ];
#define AT_GLOAD(key0) do { _Pragma("unroll") for (int j = 0; j < KJ; ++j) { const int idx = tid + 512 * j; if (idx < NKCH) { const int row = idx / KCH, c = idx % KCH; \
            kr[j] = *(const u32x4*)(Kg + (size_t)((key0) + row) * ldk + c * 8); } } \
        _Pragma("unroll") for (int j = 0; j < VJ; ++j) { const int idx = tid + 512 * j; const int row = idx >> 3, c = idx & 7; vr[j] = *(const u32x4*)(VTg + (size_t)row * ldvt + (key0) + c * 8); } } while (0)
#define AT_LSTORE(buf, vbi) do { _Pragma("unroll") for (int j = 0; j < KJ; ++j) { const int idx = tid + 512 * j; if (idx < NKCH) { const int row = idx / KCH, c = idx % KCH; \
            *(LAS u32x4*)(lds + ((buf) ? KB1 : KB0) + row * KSTR + c * 16) = kr[j]; } } \
        _Pragma("unroll") for (int j = 0; j < VJ; ++j) { const int idx = tid + 512 * j; const int row = idx >> 3, c = idx & 7; LAS unsigned char* p = lds + VB0 + (vbi) * VBSZ + row * VSTR + c * 16; \
            *(LAS u32x2*)p = (u32x2){vr[j].x, vr[j].y}; *(LAS u32x2*)(p + 8) = (u32x2){vr[j].z, vr[j].w}; } } while (0)
#define AT_KEY0(t) ((MODE == 2) ? 64 * (NT - 1 - (t)) : 64 * (t))
    AT_GLOAD(AT_KEY0(0)); AT_LSTORE(0, 0);
    __syncthreads();

    float mhat = 0.f, lrun = 0.f, R = 0.f;
    f32x16 negm;
#pragma unroll
    for (int i = 0; i < 16; ++i) negm[i] = c15;
    f32x16 o[NDB];
#pragma unroll
    for (int d = 0; d < NDB; ++d)
#pragma unroll
        for (int i = 0; i < 16; ++i) o[d][i] = 0.f;

    const bool skew = (MODE != 2) && (wid >= 4);
    u32x4 pk[4];
#pragma unroll
    for (int j = 0; j < 4; ++j) pk[j] = (u32x4){0u, 0u, 0u, 0u};
    auto pvdo = [&](const int vbi, const u32x4 (&pp)[4]) {
        const LAS unsigned char* Vb = lds + VB0 + vbi * VBSZ + (r32 + (MODE == 2 ? mm * 64 : 0)) * VSTR + hi * 8;
#pragma unroll
        for (int d = 0; d < NDB; ++d)
#pragma unroll
            for (int ks = 0; ks < 4; ++ks) { const int kb = 32 * (ks >> 1) + 16 * (ks & 1);
                const s16x4 lo = *(const LAS s16x4*)(Vb + d * 32 * VSTR + kb * 2), hh = *(const LAS s16x4*)(Vb + d * 32 * VSTR + kb * 2 + 16);
                const bf16x8 vf = __builtin_shufflevector(lo, hh, 0, 1, 2, 3, 4, 5, 6, 7);
                o[d] = MFMA32(vf, __builtin_bit_cast(bf16x8, pp[ks]), o[d]); }
    };
    int vcur = 0;
    for (int t = 0; t < NT; ++t) {
        const int cur = t & 1;
        const int vnext = vcur == 2 ? 0 : vcur + 1, vprev = vcur == 0 ? 2 : vcur - 1;
        if (MODE == 2 && SB_EARLY && t > 0) {
            const LAS unsigned* fl = (const LAS unsigned*)(lds + FLG) + ((t - 1) & 1) * 8; unsigned any = 0;
#pragma unroll
            for (int w = 0; w < 8; ++w) any |= fl[w];
            if (any == 0u) break;
        }
        if (t + 1 < NT) AT_GLOAD(AT_KEY0(t + 1));
        const int key0 = AT_KEY0(t);
        bool active;
        if (MODE == 2) active = (NT - 1 - t) <= TD; else active = t < ntw;
        bool alive = true;
        if (MODE == 2) alive = !active || __any(R > -150.f);
        if (skew && t >= 1 && (t - 1) < ntw) pvdo(vprev, pk);
        if (active && alive) {
            const LAS unsigned char* Kb = lds + (cur ? KB1 : KB0) + r32 * KSTR + mm * 128 + hi * 16;
            f32x16 p0, p1;
#pragma unroll
            for (int s = 0; s < NS; ++s) { const bf16x8 a0 = *(const LAS bf16x8*)(Kb + s * 32), a1 = *(const LAS bf16x8*)(Kb + 32 * KSTR + s * 32);
                if (s == 0) { p0 = MFMA32(a0, qf[0], negm); p1 = MFMA32(a1, qf[0], negm); } else { p0 = MFMA32(a0, qf[s], p0); p1 = MFMA32(a1, qf[s], p1); } }
            if (MODE != 2) {
                if (MODE == 0) {
                    const int qmin = q0 + 32 * rg;
                    if (key0 + 63 - qmin > -128) {
                        const LAS float* tb = (const LAS float*)(lds + TBL) + mm * 320 + (key0 - qrow + 256 + 4 * hi);
#pragma unroll
                        for (int i = 0; i < 16; ++i) { p0[i] += tb[(i & 3) + 8 * (i >> 2)]; p1[i] += tb[32 + (i & 3) + 8 * (i >> 2)]; }
                    }
                }
                float mx = __builtin_fmaxf(__builtin_fmaxf(p0[0], p0[1]), p0[2]);
#pragma unroll
                for (int i = 3; i < 15; i += 2) mx = __builtin_fmaxf(__builtin_fmaxf(mx, p0[i]), p0[i + 1]);
                mx = __builtin_fmaxf(mx, p0[15]);
#pragma unroll
                for (int i = 0; i < 16; i += 2) mx = __builtin_fmaxf(__builtin_fmaxf(mx, p1[i]), p1[i + 1]);
                mx = __builtin_fmaxf(mx, shx(mx, 32, lane));
                if (t == 0 || __any(mx > 8.f)) {
                    const float dl = (t == 0) ? mx : __builtin_fmaxf(mx, 0.f);
                    mhat += dl;
#pragma unroll
                    for (int i = 0; i < 16; ++i) { p0[i] -= dl; p1[i] -= dl; }
#pragma unroll
                    for (int i = 0; i < 16; ++i) negm[i] = c15 - mhat;
                    if (t > 0) { const float f = ex2(-dl); lrun *= f;
#pragma unroll
                        for (int d = 0; d < NDB; ++d)
#pragma unroll
                            for (int i = 0; i < 16; ++i) o[d][i] *= f; }
                }
                float rs = 0.f;
#pragma unroll
                for (int i = 0; i < 16; ++i) { p0[i] = ex2(p0[i]); p1[i] = ex2(p1[i]); rs += p0[i] + p1[i]; }
                lrun += rs;
            } else {
                f32x16 L0, L1;
                const bool diag = (NT - 1 - t) == TD;
                sb_prep(p0, L0, key0 + 4 * hi, qrow, diag); sb_prep(p1, L1, key0 + 32 + 4 * hi, qrow, diag);
                float own[8], par[8];
#pragma unroll
                for (int g = 0; g < 4; ++g) { own[g] = (L0[4 * g] + L0[4 * g + 1]) + (L0[4 * g + 2] + L0[4 * g + 3]); own[4 + g] = (L1[4 * g] + L1[4 * g + 1]) + (L1[4 * g + 2] + L1[4 * g + 3]); }
#pragma unroll
                for (int g = 0; g < 8; ++g) par[g] = shx(own[g], 32, lane);
                float so = 0.f, sp2 = 0.f;
#pragma unroll
                for (int g = 7; g >= 0; --g) {
                    const float SG = R + so + sp2 + (hi == 0 ? par[g] : 0.f);
                    float w = 0.f;
#pragma unroll
                    for (int e = 3; e >= 0; --e) { const int idx = 4 * (g & 3) + e;
                        if (g >= 4) { p1[idx] = ex2(p1[idx] + SG + w); w += L1[idx]; } else { p0[idx] = ex2(p0[idx] + SG + w); w += L0[idx]; } }
                    so += own[g]; sp2 += par[g];
                }
                R += so + sp2;
            }
#pragma unroll
            for (int j = 0; j < 4; ++j) { pk[0][j] = cvtpk(p0[2 * j], p0[2 * j + 1]); pk[1][j] = cvtpk(p0[8 + 2 * j], p0[8 + 2 * j + 1]);
                pk[2][j] = cvtpk(p1[2 * j], p1[2 * j + 1]); pk[3][j] = cvtpk(p1[8 + 2 * j], p1[8 + 2 * j + 1]); }
            if (!skew) pvdo(vcur, pk);
        }
        if (MODE == 2 && SB_EARLY) { if (lane == 0) ((LAS unsigned*)(lds + FLG))[cur * 8 + wid] = (!active || __any(R > -150.f)) ? 1u : 0u; }
        if (t + 1 < NT) AT_LSTORE(cur ^ 1, vnext);
        __syncthreads();
        vcur = vnext;
    }
    if (MODE != 2) {
        if (skew && ntw == NT) pvdo((NT - 1) % 3, pk);
        __syncthreads();
    }
#undef AT_GLOAD
#undef AT_LSTORE
#undef AT_KEY0
#define AT_STORE16(OPB, D) do { _Pragma("unroll") for (int k2 = 0; k2 < 2; ++k2) { const u32x2 snd = hi ? wq[2 * k2] : wq[2 * k2 + 1]; \
        const unsigned r0 = (unsigned)__builtin_amdgcn_ds_bpermute((lane ^ 32) << 2, (int)snd.x), r1 = (unsigned)__builtin_amdgcn_ds_bpermute((lane ^ 32) << 2, (int)snd.y); \
        const u32x4 ov = hi ? (u32x4){r0, r1, wq[2 * k2 + 1].x, wq[2 * k2 + 1].y} : (u32x4){wq[2 * k2].x, wq[2 * k2].y, r0, r1}; \
        *(u32x4*)((OPB) + 32 * (D) + 16 * k2 + 8 * hi) = ov; } } while (0)
    float inv = 1.f;
    if (MODE != 2) { const float lt = lrun + shx(lrun, 32, lane); inv = 1.f / lt; }
    if (MODE == 0) {
        LAS f32x4* X = (LAS f32x4*)lds;
        if (mm == 1) {
#pragma unroll
            for (int d = 0; d < NDB; ++d)
#pragma unroll
                for (int i4 = 0; i4 < 4; ++i4) X[(rg * 16 + d * 4 + i4) * 64 + lane] = (f32x4){o[d][4 * i4] * inv, o[d][4 * i4 + 1] * inv, o[d][4 * i4 + 2] * inv, o[d][4 * i4 + 3] * inv};
        }
        __syncthreads();
        if (mm == 0) {
            float ss = 0.f;
#pragma unroll
            for (int d = 0; d < NDB; ++d)
#pragma unroll
                for (int i4 = 0; i4 < 4; ++i4) { const f32x4 x4 = X[(rg * 16 + d * 4 + i4) * 64 + lane];
#pragma unroll
                    for (int e = 0; e < 4; ++e) { const float v = o[d][4 * i4 + e] * inv - lam * x4[e]; o[d][4 * i4 + e] = v; ss += v * v; } }
            ss += shx(ss, 32, lane);
            const float rs = rsqrtf(ss * (1.f / 128.f) + EPS) * osc;
            bf16_t* opb = Og + (size_t)qrow * ldo;
#pragma unroll
            for (int d = 0; d < NDB; ++d) { u32x2 wq[4];
#pragma unroll
                for (int g = 0; g < 4; ++g) { const f32x4 gv = *(const f32x4*)(gout + 32 * d + 8 * g + 4 * hi);
                    u32x2 w; w.x = cvtpk(o[d][4 * g] * rs * gv[0], o[d][4 * g + 1] * rs * gv[1]); w.y = cvtpk(o[d][4 * g + 2] * rs * gv[2], o[d][4 * g + 3] * rs * gv[3]);
                    wq[g] = w; }
                AT_STORE16(opb, d); }
        }
        __syncthreads();
    } else {
        float rs = inv;
        if (MODE == 1 || MODE == 2) {
            float ss = 0.f;
#pragma unroll
            for (int d = 0; d < NDB; ++d)
#pragma unroll
                for (int i = 0; i < 16; ++i) { const float v = o[d][i] * inv; ss += v * v; }
            ss += shx(ss, 32, lane);
            rs = inv * rsqrtf(ss * (1.f / 64.f) + EPS);
        }
        bf16_t* opb = Og + (size_t)qrow * ldo + (MODE == 2 ? mm * 64 : 0);
#pragma unroll
        for (int d = 0; d < NDB; ++d) { u32x2 wq[4];
#pragma unroll
            for (int g = 0; g < 4; ++g) { f32x4 gv = (f32x4){1.f, 1.f, 1.f, 1.f}; if (MODE != 3) gv = *(const f32x4*)(gout + 32 * d + 8 * g + 4 * hi);
                u32x2 w; w.x = cvtpk(o[d][4 * g] * rs * gv[0], o[d][4 * g + 1] * rs * gv[1]); w.y = cvtpk(o[d][4 * g + 2] * rs * gv[2], o[d][4 * g + 3] * rs * gv[3]);
                wq[g] = w; }
            AT_STORE16(opb, d); }
    }
#undef AT_STORE16
}
}

DI float wave_sum(float v, int lane) {
#pragma unroll
    for (int o = 1; o < 64; o <<= 1) v += shx(v, o, lane);
    return v;
}
DI void transpose_item(const float* W, int ldw, int c0, int nc, int K, const float* g, float scale, bf16_t* WT, LAS float* scr, int item, int lane, int gperm, int nbase) {
    const int nblk = nc / 32, kb = item / nblk, nb = item % nblk, k0 = 64 * kb, n0 = 32 * nb;
    float wv[32];
#pragma unroll
    for (int i = 0; i < 32; ++i) { const int kk = 2 * i + (lane >> 5); wv[i] = W[(size_t)(k0 + kk) * ldw + c0 + n0 + (lane & 31)]; }
    const float gl = g ? g[k0 + lane] * scale : scale;
#pragma unroll
    for (int i = 0; i < 32; ++i) { const int kk = 2 * i + (lane >> 5); const float gg = __builtin_bit_cast(float, __builtin_amdgcn_ds_bpermute(kk << 2, __builtin_bit_cast(int, gl)));
        scr[kk * 33 + (lane & 31)] = wv[i] * gg; }
    asm volatile("s_waitcnt lgkmcnt(0)" ::: "memory");
    const int c = lane & 7;
    const int n0g = nbase + n0;
    const int prow0 = gperm ? (n0g & ~255) + ((n0g & 32) ? 128 : 0) + 32 * ((n0g >> 6) & 3) : n0;
#pragma unroll
    for (int j = 0; j < 4; ++j) { const int n = (lane >> 3) + 8 * j; const LAS float* s = scr + (8 * c) * 33 + n;
        u32x4 o; o.x = cvtpk(s[0 * 33], s[1 * 33]); o.y = cvtpk(s[2 * 33], s[3 * 33]); o.z = cvtpk(s[4 * 33], s[5 * 33]); o.w = cvtpk(s[6 * 33], s[7 * 33]);
        *(u32x4*)(WT + (size_t)(prow0 + n) * K + k0 + 8 * c) = o; }
    asm volatile("s_waitcnt lgkmcnt(0)" ::: "memory");
}
struct Seg { const float* W; int ldw, c0, nc, K; const float* g; float scale; bf16_t* dst; int gperm, nbase; };
DI Seg get_seg(const Args& a, int l, int s) {
    unsigned char* wl = a.ws + WS_W + (size_t)l * WL_STRIDE;
    Seg r; r.g = nullptr; r.scale = 1.f; r.gperm = 0; r.nbase = 0;
    const float* w_in = a.in[4] + (size_t)l * 1024 * 2720; const float* gmix = a.in[3] + l * 1024;
    bf16_t* win = (bf16_t*)(wl + WL_IN);
    if (s < 6) { r.W = w_in; r.ldw = 2720; r.K = 1024; r.g = gmix;
        if (s == 0) { r.c0 = 0; r.nc = 1024; r.dst = win; r.gperm = 1; }
        else if (s == 1) { r.c0 = 1536; r.nc = 256; r.dst = win + 1024 * 1024; r.scale = QS64; }
        else if (s == 2) { r.c0 = 1792; r.nc = 256; r.dst = win + 1280 * 1024; }
        else if (s == 3) { r.c0 = 2304; r.nc = 416; r.dst = win + 1536 * 1024; }
        else if (s == 4) { r.c0 = 1024; r.nc = 512; r.dst = win + 2048 * 1024; }
        else { r.c0 = 2048; r.nc = 256; r.dst = win + 2560 * 1024; }
    } else if (s == 6) { r.W = a.in[12] + (size_t)l * 256 * 384; r.ldw = 384; r.c0 = 0; r.nc = 384; r.K = 256; r.g = a.in[10] + l * 256; r.dst = (bf16_t*)(wl + WL_UQ); }
    else if (s < 15) { const int h = (s - 7) & 3, isv = (s - 7) >> 2; r.W = a.in[13] + (size_t)l * 128 * 512; r.ldw = 512; r.c0 = h * 128 + isv * 64; r.nc = 64; r.K = 128; r.g = a.in[11] + l * 128;
        r.dst = (bf16_t*)(wl + (isv ? WL_UV : WL_UK)) + (isv ? h * 64 * 128 : 0); if (!isv) { r.gperm = 1; r.nbase = h * 64; } }
    else if (s == 15) { r.W = a.in[17] + (size_t)l * 1024 * 1024; r.ldw = 1024; r.c0 = 0; r.nc = 1024; r.K = 1024; r.dst = (bf16_t*)(wl + WL_OUT); }
    else if (s == 16) { r.W = a.in[20] + (size_t)l * 1024 * 256; r.ldw = 256; r.c0 = 0; r.nc = 256; r.K = 1024; r.g = a.in[18] + l * 1024; r.dst = (bf16_t*)(wl + WL_MQ); }
    else if (s == 17) { r.W = a.in[21] + (size_t)l * 1024 * 512; r.ldw = 512; r.c0 = 0; r.nc = 512; r.K = 1024; r.g = a.in[19] + l * 1024; r.dst = (bf16_t*)(wl + WL_MKV); }
    else if (s == 18) { r.W = a.in[24] + (size_t)l * 256 * 1024; r.ldw = 1024; r.c0 = 0; r.nc = 1024; r.K = 256; r.dst = (bf16_t*)(wl + WL_MO); }
    else if (s == 19) { r.W = a.in[26] + (size_t)l * 1024 * 4096; r.ldw = 4096; r.c0 = 0; r.nc = 4096; r.K = 1024; r.g = a.in[25] + l * 1024; r.dst = (bf16_t*)(wl + WL_F1); }
    else { r.W = a.in[27] + (size_t)l * 4096 * 1024; r.ldw = 1024; r.c0 = 0; r.nc = 1024; r.K = 4096; r.dst = (bf16_t*)(wl + WL_F2); }
    return r;
}
DI void row_to_bf16(const float* xrow, bf16_t* orow, float* rs, int lane) {
    const f32x4* xr = (const f32x4*)xrow + lane; f32x4 v[4]; float s = 0.f;
#pragma unroll
    for (int j = 0; j < 4; ++j) { v[j] = xr[64 * j]; s += (v[j].x * v[j].x + v[j].y * v[j].y) + (v[j].z * v[j].z + v[j].w * v[j].w); }
    s = wave_sum(s, lane);
    u32x2* o8 = (u32x2*)orow + lane;
#pragma unroll
    for (int j = 0; j < 4; ++j) { u32x2 w; w.x = cvtpk(v[j].x, v[j].y); w.y = cvtpk(v[j].z, v[j].w); o8[64 * j] = w; }
    if (lane == 0) *rs = rsqrtf(s * (1.f / 1024.f) + EPS);
}
DI void prologue_phase(const Args& a, LAS unsigned char* lds, int gw, int NGW, int wave, int lane) {
    LAS float* scr = (LAS float*)(lds + wave * 16384);
    int rot = 0;
    for (int l = 0; l < DEPTH; ++l) {
        for (int s = 0; s < 21; ++s) { const Seg sg = get_seg(a, l, s); const int items = (sg.K / 64) * (sg.nc / 32);
            int first = gw - rot; if (first < 0) first += NGW;
            for (int it = first; it < items; it += NGW) transpose_item(sg.W, sg.ldw, sg.c0, sg.nc, sg.K, sg.g, sg.scale, sg.dst, scr, it, lane, sg.gperm, sg.nbase);
            rot = (rot + items) % NGW; }
        unsigned char* wl = a.ws + WS_W + (size_t)l * WL_STRIDE;
        u32x4* z1 = (u32x4*)(wl + WL_IN + (size_t)1952 * 1024 * 2); u32x4* z2 = (u32x4*)(wl + WL_UQ + (size_t)384 * 256 * 2);
        const u32x4 zz = (u32x4){0u, 0u, 0u, 0u};
        for (int i = gw * 64 + lane; i < 96 * 1024 * 2 / 16; i += NGW * 64) z1[i] = zz;
        for (int i = gw * 64 + lane; i < 128 * 256 * 2 / 16; i += NGW * 64) z2[i] = zz;
    }
    bf16_t* XB = (bf16_t*)(a.ws + WS_XB); float* RS = (float*)(a.ws + WS_RSTD);
    for (int m0 = gw * 4; m0 < MT; m0 += NGW * 4) {
        f32x4 v[4][4]; float sq[4];
#pragma unroll
        for (int u = 0; u < 4; ++u) { const f32x4* xr = (const f32x4*)(a.in[0] + (size_t)(m0 + u) * DM) + lane; sq[u] = 0.f;
#pragma unroll
            for (int j = 0; j < 4; ++j) v[u][j] = __builtin_nontemporal_load(xr + 64 * j); }
#pragma unroll
        for (int u = 0; u < 4; ++u) {
#pragma unroll
            for (int j = 0; j < 4; ++j) sq[u] += (v[u][j].x * v[u][j].x + v[u][j].y * v[u][j].y) + (v[u][j].z * v[u][j].z + v[u][j].w * v[u][j].w); }
#pragma unroll
        for (int o = 1; o < 64; o <<= 1) {
#pragma unroll
            for (int u = 0; u < 4; ++u) sq[u] += shx(sq[u], o, lane); }
#pragma unroll
        for (int u = 0; u < 4; ++u) { u32x2* o8 = (u32x2*)(XB + (size_t)(m0 + u) * DM) + lane;
            u32x2* l8 = (u32x2*)((bf16_t*)a.out + (size_t)(m0 + u) * DM) + lane;
#pragma unroll
            for (int j = 0; j < 4; ++j) { u32x2 w; w.x = cvtpk(v[u][j].x, v[u][j].y); w.y = cvtpk(v[u][j].z, v[u][j].w); o8[64 * j] = w;
                u32x2 wl; wl.x = cvtpk(v[u][j].x - bflo(w.x), v[u][j].y - bfhi(w.x)); wl.y = cvtpk(v[u][j].z - bflo(w.y), v[u][j].w - bfhi(w.y)); l8[64 * j] = wl; }
            if (lane == 0) RS[m0 + u] = rsqrtf(sq[u] * (1.f / 1024.f) + EPS); }
    }
    bf16_t* MB = (bf16_t*)(a.ws + WS_MEMB); float* SM = (float*)(a.ws + WS_RSTDM);
    for (int m = gw; m < MROWS; m += NGW) row_to_bf16(a.in[1] + (size_t)m * DM, MB + (size_t)m * DM, SM + m, lane);
}
DI void norm8(u32x4& v, const float* g8, float extra, float invn, int xmask, int lane) {
    float f[8];
#pragma unroll
    for (int j = 0; j < 4; ++j) { f[2 * j] = bflo(v[j]); f[2 * j + 1] = bfhi(v[j]); }
    float ss = 0.f;
#pragma unroll
    for (int j = 0; j < 8; ++j) ss += f[j] * f[j];
#pragma unroll
    for (int o = 1; o <= xmask; o <<= 1) ss += shx(ss, o, lane);
    const float rs = rsqrtf(ss * invn + EPS) * extra;
#pragma unroll
    for (int j = 0; j < 4; ++j) v[j] = cvtpk(f[2 * j] * rs * g8[2 * j], f[2 * j + 1] * rs * g8[2 * j + 1]);
}
DI void post1_phase(const Args& a, int l, int gw, int NGW, int lane) {
    bf16_t* PROJ = (bf16_t*)(a.ws + WS_PROJ);
    const float* gq = a.in[5] + l * 64; const float* gk = a.in[6] + l * 64; const float* gcq = a.in[10] + l * 256; const float* gckv = a.in[11] + l * 128;
    const bool act = lane < 48; const int col3 = lane < 32 ? 1536 + 8 * lane : 1792 + 8 * ((lane - 32) & 15);
    const float* g3 = lane < 32 ? gcq + 8 * lane : gckv + 8 * ((lane - 32) & 15);
    for (int tok0 = gw * 4; tok0 < MT; tok0 += NGW * 4) {
        u32x4 v[4];
#pragma unroll
        for (int u = 0; u < 4; ++u) v[u] = *(const u32x4*)(PROJ + (size_t)(tok0 + u) * LDP + col3);
#pragma unroll
        for (int u = 0; u < 4; ++u) {
            float f[8];
#pragma unroll
            for (int j = 0; j < 4; ++j) { f[2 * j] = bflo(v[u][j]); f[2 * j + 1] = bfhi(v[u][j]); }
            float ss = 0.f;
#pragma unroll
            for (int j = 0; j < 8; ++j) ss += f[j] * f[j];
            if (!act) ss = 0.f;
            ss += shx(ss, 1, lane); ss += shx(ss, 2, lane); ss += shx(ss, 4, lane); ss += shx(ss, 8, lane);
            const float s32 = ss + shx(ss, 16, lane);
            const float rs = lane < 32 ? rsqrtf(s32 * (1.f / 256.f) + EPS) : rsqrtf(ss * (1.f / 128.f) + EPS);
#pragma unroll
            for (int j = 0; j < 4; ++j) v[u][j] = cvtpk(f[2 * j] * rs * g3[2 * j], f[2 * j + 1] * rs * g3[2 * j + 1]);
        }
#pragma unroll
        for (int u = 0; u < 4; ++u) if (act) *(u32x4*)(PROJ + (size_t)(tok0 + u) * LDP + col3) = v[u];
    }
}
DI void memk_phase(const Args& a, int gw, int NGW, int lane) {
    for (int l = 0; l < DEPTH; ++l) { bf16_t* KM = (bf16_t*)(a.ws + WS_KMEM) + (size_t)l * MROWS * 256; const float* g = a.in[23] + l * 64;
        for (int r2 = gw; r2 < MROWS / 2; r2 += NGW) { bf16_t* p = KM + (size_t)(2 * r2 + (lane >> 5)) * 256 + 8 * (lane & 31);
            u32x4 v = *(const u32x4*)p; norm8(v, g + (lane & 7) * 8, 1.f, 1.f / 64.f, 4, lane); *(u32x4*)p = v; } }
}
DI void post2_phase(const Args& a, int l, int gw, int NGW, int lane) {
    bf16_t* QM = (bf16_t*)(a.ws + WS_QM); bf16_t* KN = (bf16_t*)(a.ws + WS_KN); bf16_t* KM = (bf16_t*)(a.ws + WS_KM); bf16_t* PROJ = (bf16_t*)(a.ws + WS_PROJ);
    const float* gq = a.in[14] + l * 96; const float* gk = a.in[15] + l * 96;
    const bool act = lane < 48; const int ln = act ? lane : 47, h = ln / 12, c = ln - 12 * h;
    const bool isrope = c >= 8, isx1 = (c == 8 || c == 9); const int base12 = 12 * h;
    float freq[8];
#pragma unroll
    for (int e = 0; e < 8; ++e) freq[e] = __builtin_amdgcn_exp2f(-(float)(8 * (c & 1) + e) * (13.287712379549449f / 16.f));
    float gqo[8], gqp[8], gko[8], gkp[8];
    const int cp = isrope ? (isx1 ? c + 2 : c - 2) : c;
#pragma unroll
    for (int e = 0; e < 8; ++e) { gqo[e] = gq[8 * c + e]; gqp[e] = gq[8 * cp + e]; gko[e] = gk[8 * c + e]; gkp[e] = gk[8 * cp + e]; }
    const int plane = isrope ? (isx1 ? lane + 2 : lane - 2) : lane;
    for (int it0 = gw * 4; it0 < MT; it0 += NGW * 4) {
        u32x4 v[4];
#pragma unroll
        for (int u = 0; u < 4; ++u) { const int isk = 1, tok = it0 + u;
            const bf16_t* src = !isk ? QM + (size_t)tok * 512 + h * 96 + 8 * c : (c < 8 ? KN + (size_t)tok * 256 + h * 64 + 8 * c : PROJ + (size_t)tok * LDP + 1920 + 8 * (c - 8));
            v[u] = *(const u32x4*)src; }
#pragma unroll
        for (int u = 0; u < 4; ++u) { const int isk = 1, tok = it0 + u, pos = tok & (SEQ - 1);
            float f[8], pf[8];
#pragma unroll
            for (int j = 0; j < 4; ++j) { f[2 * j] = bflo(v[u][j]); f[2 * j + 1] = bfhi(v[u][j]); }
            float ss = 0.f;
#pragma unroll
            for (int j = 0; j < 8; ++j) ss += f[j] * f[j];
            ss += shx(ss, 1, lane); ss += shx(ss, 2, lane);
            const float t0 = __builtin_bit_cast(float, __builtin_amdgcn_ds_bpermute((base12) << 2, __builtin_bit_cast(int, ss)));
            const float t1 = __builtin_bit_cast(float, __builtin_amdgcn_ds_bpermute((base12 + 4) << 2, __builtin_bit_cast(int, ss)));
            const float t2 = __builtin_bit_cast(float, __builtin_amdgcn_ds_bpermute((base12 + 8) << 2, __builtin_bit_cast(int, ss)));
            const float rs = rsqrtf((t0 + t1 + t2) * (1.f / 96.f) + EPS);
#pragma unroll
            for (int j = 0; j < 4; ++j) { const unsigned pw = (unsigned)__builtin_amdgcn_ds_bpermute(plane << 2, (int)v[u][j]); pf[2 * j] = bflo(pw); pf[2 * j + 1] = bfhi(pw); }
            const float scale = isk ? 1.f : QS96; const float fpos = (float)pos;
            u32x4 w;
            float y[8];
#pragma unroll
            for (int e = 0; e < 8; ++e) {
                const float xo = f[e] * rs * (isk ? gko[e] : gqo[e]);
                float r_ = xo;
                if (isrope) {
                    const float xp = pf[e] * rs * (isk ? gkp[e] : gqp[e]);
                    const float ang = fpos * freq[e];
                    const float n = rintf(ang * 0.15915494309189535f);
                    float r = fmaf(-n, 6.28318548202514648f, ang); r = fmaf(-n, -1.74845553146951715e-7f, r);
                    const float cs = __cosf(r), sn = __sinf(r);
                    r_ = isx1 ? (xo * cs - xp * sn) : (xo * cs + xp * sn);
                }
                y[e] = r_ * scale;
            }
#pragma unroll
            for (int j = 0; j < 4; ++j) w[j] = cvtpk(y[2 * j], y[2 * j + 1]);
            bf16_t* dst = !isk ? QM + (size_t)tok * 512 + h * 96 + 8 * c : KM + (size_t)tok * 384 + h * 96 + 8 * c;
            if (act) *(u32x4*)dst = w;
        }
    }
}


#define XB_TMO      128
#define XB_XCNT(j)  (256  + 64 * (j))
#define XB_XSUB(j)  (1280 + 64 * (j))
#define XB_XGEN(j)  (2304 + 64 * (j))
#define XB_TOP      3328
#define XB_TOPGEN   3392
#define XCD_BAR_WORDS 3456
#define XB_SPIN_CAP (1u << 18)

__device__ __forceinline__ unsigned xb_ld(unsigned* p)              { return __hip_atomic_load(p, __ATOMIC_RELAXED, __HIP_MEMORY_SCOPE_AGENT); }
__device__ __forceinline__ unsigned xb_add(unsigned* p, unsigned v) { return __hip_atomic_fetch_add(p, v, __ATOMIC_RELAXED, __HIP_MEMORY_SCOPE_AGENT); }
__device__ __forceinline__ unsigned xb_xcc_id() { return (unsigned)__builtin_amdgcn_s_getreg((3 << 11) | 20) & 0xFu; }
#define XB_SPIN(cond, bar) do { unsigned _sp = 0; while (cond) { __builtin_amdgcn_s_sleep(1); \
    if ((++_sp & 255u) == 0u) { if (xb_ld(&(bar)[XB_TMO])) break; if (_sp > XB_SPIN_CAP) { atomicAdd(&(bar)[XB_TMO], 1u); break; } } } } while (0)

struct XcdBarrier {
    unsigned* bar; unsigned x;
    volatile LAS unsigned* st;
};

__device__ __forceinline__ XcdBarrier xcd_barrier_post(unsigned* bar, volatile LAS unsigned* st) {
    XcdBarrier b; b.bar = bar; b.x = xb_xcc_id(); b.st = st;
    if (threadIdx.x == 0) (void)xb_add(&bar[XB_XCNT(b.x)], 1u);
    return b;
}
__device__ __forceinline__ void xcd_barrier_complete(unsigned* bar, unsigned x, unsigned& nloc, unsigned& nx) {
    const unsigned G = gridDim.x * gridDim.y * gridDim.z;
    unsigned sum, cnt, mine, sp = 0u;
    for (;;) {
        sum = 0u; cnt = 0u; mine = 0u;
#pragma unroll
        for (unsigned j = 0; j < 16; ++j) { const unsigned c = xb_ld(&bar[XB_XCNT(j)]); sum += c; cnt += (c > 0u) ? 1u : 0u; mine = (j == x) ? c : mine; }
        if (sum == G) break;
        __builtin_amdgcn_s_sleep(1);
        if ((++sp & 255u) == 0u) { if (xb_ld(&bar[XB_TMO])) break; if (sp > XB_SPIN_CAP) { atomicAdd(&bar[XB_TMO], 1u); break; } }
    }
    nloc = mine > 0u ? mine : 1u; nx = cnt > 0u ? cnt : 1u;
}

__device__ __forceinline__ void xcd_barrier(const XcdBarrier& b) {
    asm volatile("s_waitcnt vmcnt(0)" ::: "memory");
    __syncthreads();
    if (threadIdx.x == 0) {
        unsigned* bar = b.bar;
        __builtin_amdgcn_s_waitcnt(0);
        unsigned nloc = b.st[0], nx = b.st[1];
        if (nloc == 0u) { xcd_barrier_complete(bar, b.x, nloc, nx); b.st[0] = nloc; b.st[1] = nx; }
        const unsigned old = xb_add(&bar[XB_XSUB(b.x)], 1u);
        const unsigned gen = old / nloc;
        if (old + 1u == (gen + 1u) * nloc) {
            __builtin_amdgcn_fence(__ATOMIC_RELEASE, "agent");
            asm volatile("s_waitcnt vmcnt(0)" ::: "memory");
            const unsigned og = xb_add(&bar[XB_TOP], 1u);
            const unsigned tg = og / nx;
            if (og + 1u == (tg + 1u) * nx) xb_add(&bar[XB_TOPGEN], 1u);
            else XB_SPIN(xb_ld(&bar[XB_TOPGEN]) == tg, bar);
            __builtin_amdgcn_fence(__ATOMIC_ACQUIRE, "agent");
            xb_add(&bar[XB_XGEN(b.x)], 1u);
            asm volatile("s_waitcnt vmcnt(0)" ::: "memory");
        } else {
            XB_SPIN(xb_ld(&bar[XB_XGEN(b.x)]) == gen, bar);
            __builtin_amdgcn_fence(__ATOMIC_ACQUIRE, "agent");
            asm volatile("s_waitcnt vmcnt(0)" ::: "memory");
        }
    }
    __syncthreads();
}


constexpr int PH_PER_LAYER = 11, PH_PRE = 3, N_PHASES = PH_PRE + DEPTH * PH_PER_LAYER;

struct Job { pg8::Gemm g; int kind; bf16_t* O; int ldc; const float* SS; float invn; const float* base; float* out; float* SSo; };

__global__ void __launch_bounds__(512, 2) mk_fwd(Args a) {
    extern __shared__ __attribute__((aligned(16))) unsigned char lds_raw[];
    LAS unsigned char* lds = (LAS unsigned char*)lds_raw;
    cg::grid_group grid = cg::this_grid();
    const int bx = blockIdx.x;
    bool dup = false;
    volatile LAS unsigned* bst = (volatile LAS unsigned*)(lds + 131072 + 64);
    if (threadIdx.x < 2) bst[threadIdx.x] = 0u;
    __syncthreads();
    const XcdBarrier xbar = xcd_barrier_post((unsigned*)(a.ws + WS_BAR), bst);
    int nsync = 0;
#define GRID_BAR() do { if (nsync == 0) grid.sync(); else xcd_barrier(xbar); ++nsync; } while (0)
    for (int ph = a.ph_lo; ph < a.ph_hi; ++ph) {
    unsigned char* ws = a.ws; asm volatile("" : "+s"(ws));
    bf16_t* XB = (bf16_t*)(ws + WS_XB); bf16_t* PROJ = (bf16_t*)(ws + WS_PROJ); bf16_t* VT = (bf16_t*)(ws + WS_VT); bf16_t* QM = (bf16_t*)(ws + WS_QM);
    bf16_t* KN = (bf16_t*)(ws + WS_KN); bf16_t* KM = (bf16_t*)(ws + WS_KM); bf16_t* VTM = (bf16_t*)(ws + WS_VTM); bf16_t* HB = (bf16_t*)(ws + WS_H);
    bf16_t* Y = (bf16_t*)(ws + WS_Y); bf16_t* QMEM = (bf16_t*)(ws + WS_QMEM); bf16_t* OMEM = (bf16_t*)(ws + WS_OMEM); bf16_t* MEMB = (bf16_t*)(ws + WS_MEMB);
    bf16_t* XLO = (bf16_t*)a.out;
    bf16_t* XLO2 = (bf16_t*)(ws + WS_PROJ);
    float* SS = (float*)(ws + WS_SS); float* SM = (float*)(ws + WS_RSTDM); float* RS = (float*)(ws + WS_RSTD); float* CQS = (float*)(ws + WS_CQS);

        int tid_ = threadIdx.x; asm volatile("" : "+v"(tid_));
        int G_ = gridDim.x; asm volatile("" : "+s"(G_)); const int G = G_, NGW = G * 8;
        const int tid = tid_, lane = tid & 63, wave = __builtin_amdgcn_readfirstlane(tid >> 6), gw = bx * 8 + wave;
        int l = 0, sub = -1;
        if (ph >= PH_PRE) { l = (ph - PH_PRE) / PH_PER_LAYER; sub = (ph - PH_PRE) % PH_PER_LAYER; }
        if (sub == 1 || sub == 3) continue;
        unsigned char* wl = ws + WS_W + (size_t)l * WL_STRIDE;
        bf16_t* KMEMl = (bf16_t*)(ws + WS_KMEM) + (size_t)l * MROWS * 256; bf16_t* VTMEMl = (bf16_t*)(ws + WS_VTMEM) + (size_t)l * 256 * MROWS;
        int njobs = 0;
        if (ph == 1) njobs = 2 * DEPTH;
        else if (sub == 0) njobs = 2; else if (sub == 2) njobs = 3; else if (sub == 5 || sub == 6 || sub == 8 || sub == 9 || sub == 10) njobs = 1;
        if (ph == 0) prologue_phase(a, lds, gw, NGW, wave, lane);
        else if (ph == 2) memk_phase(a, gw, NGW, lane);
        else if (sub == 1) post1_phase(a, l, gw, NGW, lane);
        else if (sub == 3) post2_phase(a, l, gw, NGW, lane);
        else if (sub == 4) {
            const float* lp = a.in[7] + l * 256;
            const float d1 = wave_sum(lp[lane] * lp[64 + lane], lane), d2 = wave_sum(lp[128 + lane] * lp[192 + lane], lane);
            const float lam_init = 0.8f - 0.6f * expf(-0.3f * (float)l), lam = expf(d1) - expf(d2) + lam_init;
            const bool xl = (G == 256);
            for (int jj = 0; ; ++jj) {
                int cls, bh;
                if (xl) { if (jj >= 16) break; const int w = ((bx >> 3) + 4 * (jj >> 1)) & 31; cls = (jj & 1) ? 31 - w : w; bh = (bx & 7) + 8 * jj; }
                else { const int k = jj * G + ((jj & 1) ? G - 1 - bx : bx); if (k >= 4096) break; cls = k >> 7; bh = k & 127; }
                const int b = bh >> 2, h = bh & 3;
                int code;
                { const unsigned char tab[32] = {15, 14, 16 + 7, 13, 12, 16 + 6, 11, 10, 16 + 5, 9, 8, 16 + 4, 7, 16 + 3, 6, 32 + 7, 32 + 6, 32 + 5, 32 + 4, 32 + 3, 32 + 2, 32 + 1,
                                                 5, 16 + 2, 4, 3, 32 + 0, 16 + 1, 2, 1, 16 + 0, 0}; code = tab[cls]; }
                const int typ = code >> 4, lvl = code & 15, grp = typ == 1 ? 0 : (typ == 2 ? 3 : 1);
                if (PROBE_ATT_ONLY >= 0 && dup && typ != PROBE_ATT_ONLY) continue;
                const size_t rb = (size_t)b * SEQ;
                if (grp == 0) at::attn_unit<1>(lds, QM + rb * 512 + h * 96, 512, KM + rb * 384 + h * 96, 384, VTM + (size_t)(h * 64) * MT + rb, MT, Y + rb * DM + 768 + h * 64, DM,
                                               256 * lvl, 4 * lvl + 4, a.in[16] + l * 64, nullptr, 0.f, 1.f, a.in[14] + l * 96);
                else if (grp == 3) { const int hp = h >> 1, i = 2 * lvl + (h & 1);
                    at::attn_unit<2>(lds, PROJ + rb * LDP + 1024 + hp * 128, LDP, PROJ + rb * LDP + 1280 + hp * 128, LDP, VT + (size_t)(512 + hp * 128) * MT + rb, MT, Y + rb * DM + 512 + hp * 128, DM,
                                     128 * i, 2 * i + 2, a.in[9] + l * 64, nullptr, 0.f, 1.f, nullptr); }
                else { const int i = lvl;
                    at::attn_unit<0>(lds, PROJ + rb * LDP + h * 128, LDP, PROJ + rb * LDP + 512 + h * 128, LDP, VT + (size_t)(h * 128) * MT + rb, MT, Y + rb * DM + h * 128, DM,
                                     128 * i, 2 * i + 2, a.in[8] + l * 128, a.in[2] + h * 2, lam, 1.f - lam_init, nullptr); }
            }
        } else if (sub == 7) {
            for (int u = bx; u < 1024; u += G) { const int qb = u & 7, bh = u >> 3, b = bh >> 2, h = bh & 3; const size_t rb = (size_t)b * SEQ;
                at::attn_unit<3>(lds, QMEM + rb * 256 + h * 64, 256, KMEMl + (size_t)b * NMEM * 256 + h * 64, 256, VTMEMl + (size_t)(h * 64) * MROWS + b * NMEM, MROWS, OMEM + rb * 256 + h * 64, 256,
                                 256 * qb, 4, nullptr, nullptr, 0.f, 1.f, a.in[22] + l * 64); }
        }
        for (int j = 0; j < njobs; ++j) {
            int Gj = G, cj = bx;
            if (ph == 1 && G == 256) { if (j != (bx >> 5)) continue; Gj = 32; cj = bx & 31; }
            Job J; J.SS = nullptr; J.invn = 0.f; J.SSo = SS; J.base = nullptr; J.out = nullptr; J.O = nullptr; J.ldc = 0; J.kind = 0;
            if (ph == 1) { const int ll = j >> 1; unsigned char* w2 = ws + WS_W + (size_t)ll * WL_STRIDE; const bf16_t* wkv = (const bf16_t*)(w2 + WL_MKV);
                if ((j & 1) == 0) { J.g = pg8::Gemm{MEMB, wkv, MROWS, 256, 1024, 1024, 1024}; J.kind = 0; J.O = (bf16_t*)(ws + WS_KMEM) + (size_t)ll * MROWS * 256; J.ldc = 256; J.SS = SM; }
                else { J.g = pg8::Gemm{wkv + 256 * 1024, MEMB, 256, MROWS, 1024, 1024, 1024}; J.kind = 2; J.O = (bf16_t*)(ws + WS_VTMEM) + (size_t)ll * 256 * MROWS; J.ldc = MROWS; J.SS = SM; }
            } else if (sub == 0) { const bf16_t* win = (const bf16_t*)(wl + WL_IN);
                if (j == 0) { J.g = pg8::Gemm{XB, win, MT, 2048, 1024, 1024, 1024}; J.kind = 4; J.O = PROJ; J.ldc = LDP; J.SS = RS; J.base = a.in[5] + l * 64; J.out = const_cast<float*>(a.in[6] + l * 64); J.SSo = CQS; }
                else { J.g = pg8::Gemm{win + 2048 * 1024, XB, 768, MT, 1024, 1024, 1024}; J.kind = 2; J.O = VT; J.ldc = MT; J.SS = RS; }
            } else if (sub == 2) {
                if (j == 0) { J.g = pg8::Gemm{PROJ + 1536, (const bf16_t*)(wl + WL_UQ), MT, 512, 256, LDP, 256}; J.kind = 0; J.O = QM; J.ldc = 512; J.SS = CQS; J.invn = 1.f / 256.f; }
                else if (j == 1) { J.g = pg8::Gemm{PROJ + 1792, (const bf16_t*)(wl + WL_UK), MT, 256, 128, LDP, 128}; J.kind = 5; J.O = KM; J.ldc = 384; J.SS = CQS + (size_t)MT * 4; J.base = a.in[15] + l * 96; J.out = (float*)PROJ; J.SSo = CQS + (size_t)2 * MT * 4; }
                else { J.g = pg8::Gemm{(const bf16_t*)(wl + WL_UV), PROJ + 1792, 256, MT, 128, 128, LDP}; J.kind = 2; J.O = VTM; J.ldc = MT; J.SS = CQS + (size_t)MT * 4; J.invn = 1.f / 128.f; }
            } else if (sub == 5) { J.g = pg8::Gemm{Y, (const bf16_t*)(wl + WL_OUT), MT, 1024, 1024, 1024, 1024}; J.kind = 3; J.SS = (const float*)XLO; J.O = (l == DEPTH - 1) ? XLO2 : XLO; }
            else if (sub == 6) { J.g = pg8::Gemm{XB, (const bf16_t*)(wl + WL_MQ), MT, 256, 1024, 1024, 1024}; J.kind = 0; J.O = QMEM; J.ldc = 256; J.SS = RS; }
            else if (sub == 8) { J.g = pg8::Gemm{OMEM, (const bf16_t*)(wl + WL_MO), MT, 1024, 256, 256, 256}; J.kind = 3;
                if (l == DEPTH - 1) { J.SS = (const float*)XLO2; J.out = a.out; } else { J.SS = (const float*)XLO; J.O = XLO; } }
            else if (sub == 9) { J.g = pg8::Gemm{XB, (const bf16_t*)(wl + WL_F1), MT, 4096, 1024, 1024, 1024}; J.kind = 1; J.O = HB; J.ldc = 4096; J.SS = RS; }
            else { J.g = pg8::Gemm{HB, (const bf16_t*)(wl + WL_F2), MT, 1024, 4096, 4096, 4096}; J.kind = 3;
                if (l == DEPTH - 1) { J.base = a.out; J.out = a.out; } else { J.SS = (const float*)XLO; J.O = XLO; } }
            pg8::StaticOrder S; S.init(J.g.M, J.g.N, Gj, cj, 0);
            if (J.SS == RS && !(l == 0 && sub == 0)) {
                pg8::Unit fu;
                for (int i = 0; S.next(i, fu); ++i) if (tid < 256) { const int row = (J.kind == 2 ? fu.pn : fu.pm) * 256 + tid;
                    const f32x4* p = (const f32x4*)(SS + (size_t)row * 16); const f32x4 q0 = p[0], q1 = p[1], q2 = p[2], q3 = p[3];
                    const float sm = (((q0.x + q0.y) + (q0.z + q0.w)) + ((q1.x + q1.y) + (q1.z + q1.w))) + (((q2.x + q2.y) + (q2.z + q2.w)) + ((q3.x + q3.y) + (q3.z + q3.w)));
                    RS[row] = rsqrtf(sm * (1.f / 1024.f) + EPS); }
                __syncthreads();
            }
            { pg8::EpiAny E{J.kind, J.O, J.ldc, J.SS, J.invn, J.base, J.out, XB, J.SSo}; pg8::gemm_phase(lds, J.g, S, E); }
            __syncthreads();
        }
        if (PROBE_COND && !dup) { dup = true; GRID_BAR(); ph -= PROBE_BACK; continue; }
        if (PROBE_COND) dup = false;
        if (ph + 1 < a.ph_hi) GRID_BAR();
    }
}

extern "C" void kernel_launch(void* const* d_in, const int* in_sizes, int n_in, void* d_out, int out_size, void* d_ws, size_t ws_size, hipStream_t stream) {
    static int grid = 0;
    if (grid == 0) {
        if (n_in != 28 || in_sizes[0] != MT * DM || out_size != MT * DM || ws_size < WS_END) {
            fprintf(stderr, "kernel_launch: unexpected shapes (n_in %d, in0 %d, out %d, ws %zu); nothing launched\n", n_in, n_in > 0 ? in_sizes[0] : -1, out_size, ws_size); grid = -1; return; }
        int dev = 0, cus = 0, per_cu = 0;
        hipGetDevice(&dev); hipDeviceGetAttribute(&cus, hipDeviceAttributeMultiprocessorCount, dev);
        if (hipFuncSetAttribute((const void*)mk_fwd, hipFuncAttributeMaxDynamicSharedMemorySize, LDS_BYTES) != hipSuccess) { fprintf(stderr, "kernel_launch: hipFuncSetAttribute failed\n"); grid = -1; return; }
        if (hipOccupancyMaxActiveBlocksPerMultiprocessor(&per_cu, (const void*)mk_fwd, 512, LDS_BYTES) != hipSuccess || per_cu < 1) { fprintf(stderr, "kernel_launch: occupancy query says %d\n", per_cu); per_cu = 1; }
        (void)hipGetLastError();
        grid = cus * (per_cu > 1 ? 1 : per_cu);
    }
    if (grid < 0) return;
    Args a{};
    for (int i = 0; i < 28; ++i) a.in[i] = (const float*)d_in[i];
    a.out = (float*)d_out; a.ws = (unsigned char*)d_ws;
    (void)hipMemsetAsync((unsigned char*)d_ws + WS_BAR, 0, 16384, stream);
    a.ph_lo = 0; a.ph_hi = N_PHASES;
    void* args[] = {&a};
    hipError_t e = hipLaunchCooperativeKernel((const void*)mk_fwd, dim3(grid), dim3(512), args, LDS_BYTES, stream);
    if (e != hipSuccess) fprintf(stderr, "kernel_launch: cooperative launch failed: %s (grid %d)\n", hipGetErrorString(e), grid);
}
```
